# Optimizing an MI355X kernel written in HIP

```python
import math
import jax, jax.numpy as jnp
from jax import lax
import numpy as np

D_MODEL = 2048
BATCH = 4
SEQ = 2048
DEPTH = 2

A_HEADS = 8
A_EXPAND = 128
A_HEAD_V = 128
A_WIDTH = A_HEADS * A_EXPAND
A_CHUNK = 16
B_GROUPS = ((128, 1), (512, 4), (2048, 16))
B_HEADS_PER_GROUP = 4
B_HEADS = B_HEADS_PER_GROUP * len(B_GROUPS)
B_HEAD_DIM = 64
B_WIDTH = B_HEADS * B_HEAD_DIM
B_OUT = B_HEADS_PER_GROUP * B_HEAD_DIM
C_WIDTH = 768
C_KERNEL = 31
REL_BUCKETS = 32
REL_MAX_DIST = 2048
D_FF = 4 * D_MODEL
N_BRANCH = 3
IN_SPLITS = (A_WIDTH, A_WIDTH, A_HEADS * A_HEAD_V, A_HEADS * A_HEAD_V,
             B_WIDTH, B_WIDTH, B_WIDTH, C_WIDTH, C_WIDTH)
IN_WIDTH = sum(IN_SPLITS)
EPS = 1e-6
MASK_VALUE = -1e30
TINY = 1e-30

kernel_name = "hybrid_hgrn2_dilated_conformer_block"


def rms_norm(x, w):
    xf = x.astype(jnp.float32)
    y = xf * lax.rsqrt(jnp.mean(xf * xf, axis=-1, keepdims=True) + EPS)
    return (y * w).astype(x.dtype)


def layer_norm(x, g, b):
    xf = x.astype(jnp.float32)
    mu = jnp.mean(xf, axis=-1, keepdims=True)
    var = jnp.mean(jnp.square(xf - mu), axis=-1, keepdims=True)
    return ((xf - mu) * lax.rsqrt(var + EPS) * g + b).astype(x.dtype)


def split_cols(a, sizes):
    idx = [int(v) for v in np.cumsum(sizes)[:-1]]
    return jnp.split(a, idx, axis=-1)


def hgrn2_mixer(q_pre, f_pre, inp, og, lb, norm_w):
    f32 = jnp.float32
    Bsz, S, _ = q_pre.shape
    H, K, V, C = A_HEADS, A_EXPAND, A_HEAD_V, A_CHUNK
    N = S // C

    def chunks(a, d):
        return a.astype(f32).reshape(Bsz, N, C, H, d).transpose(0, 3, 1, 2, 4)

    lb = jnp.maximum(lb.astype(f32), 0.0).reshape(H, K)[None, :, None, None, :]
    z = chunks(f_pre, K)
    log_f = jnp.logaddexp(jnp.log(lb + TINY), jnp.log1p(-lb) + jax.nn.log_sigmoid(z))
    k = (1.0 - lb) * jax.nn.sigmoid(-z)
    q = jax.nn.silu(chunks(q_pre, K))
    v = chunks(inp, V)
    b = jnp.cumsum(log_f, axis=3)
    causal = jnp.tril(jnp.ones((C, C), bool))
    decay = jnp.exp(jnp.where(causal[:, :, None],
                              b[..., :, None, :] - b[..., None, :, :], MASK_VALUE))
    attn = jnp.einsum('bhntk,bhntsk,bhnsk->bhnts', q, decay, k)
    o = jnp.einsum('bhnts,bhnsv->bhntv', attn, v)
    b_last = b[..., -1, :]
    delta = jnp.einsum('bhnck,bhncv->bhnkv', k * jnp.exp(b_last[..., None, :] - b), v)

    def step(state, xs):
        dec, dlt = xs
        return dec[..., None] * state + dlt, state

    _, s_prev = lax.scan(step, jnp.zeros((Bsz, H, K, V), f32),
                         (jnp.moveaxis(jnp.exp(b_last), 2, 0), jnp.moveaxis(delta, 2, 0)))
    s_prev = jnp.moveaxis(s_prev, 0, 2)
    o = o + jnp.einsum('bhnck,bhnkv->bhncv', q * jnp.exp(b), s_prev)
    o = o.transpose(0, 2, 3, 1, 4).reshape(Bsz, S, H, V)
    o = rms_norm(o, norm_w) * jax.nn.silu(og.astype(f32).reshape(Bsz, S, H, V))
    return o.reshape(Bsz, S, H * V).astype(q_pre.dtype)


def t5_bucket(dist):
    exact = REL_BUCKETS // 2
    d = jnp.maximum(dist, 1).astype(jnp.float32)
    large = exact + (jnp.log(d / exact) / math.log(REL_MAX_DIST / exact)
                     * (REL_BUCKETS - exact)).astype(jnp.int32)
    return jnp.where(dist < exact, dist, jnp.clip(large, exact, REL_BUCKETS - 1))


def dilated_window_group(q, k, v, bias_tab, window, dil):
    f32 = jnp.float32
    Bsz, S, H, Dh = q.shape
    J = window // dil
    Q = J
    L = S // dil
    nb = -(-L // Q)
    Lp = nb * Q

    def strided(a):
        a = a.reshape(Bsz, L, dil, H, Dh).transpose(0, 2, 1, 3, 4)
        return jnp.pad(a, ((0, 0), (0, 0), (0, Lp - L), (0, 0), (0, 0)))

    def band(a):
        a = jnp.pad(a, ((0, 0), (0, 0), (Q, 0), (0, 0), (0, 0))).reshape(Bsz, dil, nb + 1, Q, H, Dh)
        return jnp.concatenate([a[:, :, :-1], a[:, :, 1:]], axis=3)

    qb = strided(q).reshape(Bsz, dil, nb, Q, H, Dh)
    kb, vb = band(strided(k)), band(strided(v))
    steps = jnp.arange(Q)[:, None] + Q - jnp.arange(2 * Q)[None, :]
    key_pos = jnp.arange(nb)[:, None] * Q + jnp.arange(2 * Q)[None, :] - Q
    valid = ((steps >= 0) & (steps <= J))[None] & (key_pos >= 0)[:, None, :]
    bias = bias_tab[t5_bucket(jnp.clip(steps, 0, J) * dil)].transpose(2, 0, 1)
    logits = (jnp.einsum('brnqhd,brnkhd->brnhqk', qb, kb).astype(f32) * (Dh ** -0.5)
              + bias.astype(f32))
    logits = jnp.where(valid[None, None, :, None], logits, MASK_VALUE)
    m = jnp.max(logits, axis=-1, keepdims=True)
    p = jnp.exp(logits - m)
    z = jnp.sum(p, axis=-1, keepdims=True)
    o = jnp.einsum('brnhqk,brnkhd->brnqhd', p / z, vb.astype(f32))
    lse = (m + jnp.log(z))[..., 0]
    o = o.reshape(Bsz, dil, Lp, H, Dh)[:, :, :L].transpose(0, 2, 1, 3, 4).reshape(Bsz, S, H, Dh)
    lse = (lse.transpose(0, 1, 2, 4, 3).reshape(Bsz, dil, Lp, H)[:, :, :L]
           .transpose(0, 2, 1, 3).reshape(Bsz, S, H))
    return o, lse


def dilated_attention_mixer(q, k, v, rel_bias):
    Bsz, S, _ = q.shape
    shp = (Bsz, S, B_HEADS, B_HEAD_DIM)
    q, k, v = q.reshape(shp), k.reshape(shp), v.reshape(shp)
    outs, lses = [], []
    for g, (window, dil) in enumerate(B_GROUPS):
        hs = slice(g * B_HEADS_PER_GROUP, (g + 1) * B_HEADS_PER_GROUP)
        o, lse = dilated_window_group(q[:, :, hs], k[:, :, hs], v[:, :, hs],
                                      rel_bias[:, hs], window, dil)
        outs.append(o)
        lses.append(lse)
    alpha = jax.nn.softmax(jnp.stack(lses, axis=0), axis=0)
    out = jnp.sum(alpha[..., None] * jnp.stack(outs, axis=0), axis=0)
    return out.reshape(Bsz, S, B_OUT).astype(q.dtype)


def conv_module(a, gate, conv_w, conv_b, ln_g, ln_b):
    u = a * jax.nn.sigmoid(gate)
    y = lax.conv_general_dilated(u, conv_w[:, None, :], window_strides=(1,),
                                 padding=((C_KERNEL - 1, 0),),
                                 dimension_numbers=('NWC', 'WIO', 'NWC'),
                                 feature_group_count=C_WIDTH) + conv_b
    return jax.nn.silu(layer_norm(y, ln_g, ln_b))


def setup_inputs(seed: int = 0) -> dict:
    key = jax.random.key(seed)
    ks = jax.random.split(key, 26)
    f32 = jnp.float32

    def nrm(k, shape, scale):
        return jax.random.normal(k, shape, f32) * scale

    D = D_MODEL
    return {
        "x": nrm(ks[0], (BATCH, SEQ, D), 1.0),
        "c": nrm(ks[1], (BATCH, D), 1.0),
        "rel_bias": nrm(ks[2], (REL_BUCKETS, B_HEADS), 0.5),
        "hgrn_lb_logits": nrm(ks[3], (DEPTH, A_WIDTH), 1.0),
        "w_ada": nrm(ks[4], (DEPTH, D, 6 * D), 0.3 * D ** -0.5),
        "b_ada": nrm(ks[5], (DEPTH, 6 * D), 0.02),
        "mix_norm_pre": 1.0 + nrm(ks[6], (DEPTH, D), 0.05),
        "mix_norm_post": 1.0 + nrm(ks[7], (DEPTH, D), 0.05),
        "w_in": nrm(ks[8], (DEPTH, D, IN_WIDTH), D ** -0.5),
        "w_gate": nrm(ks[9], (DEPTH, D, N_BRANCH * D), D ** -0.5),
        "b_gate": nrm(ks[10], (DEPTH, N_BRANCH * D), 0.02),
        "hgrn_norm_w": 1.0 + nrm(ks[11], (DEPTH, A_HEAD_V), 0.05),
        "conv_w": nrm(ks[12], (DEPTH, C_KERNEL, C_WIDTH), C_KERNEL ** -0.5),
        "conv_b": nrm(ks[13], (DEPTH, C_WIDTH), 0.02),
        "conv_ln_g": 1.0 + nrm(ks[14], (DEPTH, C_WIDTH), 0.05),
        "conv_ln_b": nrm(ks[15], (DEPTH, C_WIDTH), 0.02),
        "w_a_out": nrm(ks[16], (DEPTH, A_HEADS * A_HEAD_V, D), (A_HEADS * A_HEAD_V) ** -0.5),
        "w_b_out": nrm(ks[17], (DEPTH, B_OUT, D), B_OUT ** -0.5),
        "w_c_out": nrm(ks[18], (DEPTH, C_WIDTH, D), C_WIDTH ** -0.5),
        "w_o": nrm(ks[19], (DEPTH, D, D), D ** -0.5),
        "mlp_norm_pre": 1.0 + nrm(ks[20], (DEPTH, D), 0.05),
        "mlp_norm_post": 1.0 + nrm(ks[21], (DEPTH, D), 0.05),
        "w_up": nrm(ks[22], (DEPTH, D, D_FF), D ** -0.5),
        "w_down": nrm(ks[23], (DEPTH, D_FF, D), D_FF ** -0.5),
    }


def reference(x, c, rel_bias, hgrn_lb_logits, w_ada, b_ada, mix_norm_pre, mix_norm_post,
              w_in, w_gate, b_gate, hgrn_norm_w, conv_w, conv_b, conv_ln_g, conv_ln_b,
              w_a_out, w_b_out, w_c_out, w_o, mlp_norm_pre, mlp_norm_post, w_up, w_down):
    Bsz, S, D = x.shape
    sm = jax.nn.softmax(hgrn_lb_logits.astype(jnp.float32), axis=0)
    lower_bounds = jnp.cumsum(sm, axis=0) - sm[0]
    c_act = jax.nn.silu(c)
    for l in range(DEPTH):
        mod = c_act @ w_ada[l] + b_ada[l]
        sh1, sc1, g1, sh2, sc2, g2 = jnp.split(mod[:, None, :], 6, axis=-1)

        h = rms_norm(x, mix_norm_pre[l]) * (1.0 + sc1) + sh1
        a_q, a_f, a_i, a_g, b_q, b_k, b_v, c_a, c_g = split_cols(h @ w_in[l], IN_SPLITS)
        ya = hgrn2_mixer(a_q, a_f, a_i, a_g, lower_bounds[l], hgrn_norm_w[l])
        yb = dilated_attention_mixer(b_q, b_k, b_v, rel_bias)
        yc = conv_module(c_a, c_g, conv_w[l], conv_b[l], conv_ln_g[l], conv_ln_b[l])
        gates = jax.nn.sigmoid(h @ w_gate[l] + b_gate[l]).reshape(Bsz, S, N_BRANCH, D)
        merged = (gates[:, :, 0] * (ya @ w_a_out[l])
                  + gates[:, :, 1] * (yb @ w_b_out[l])
                  + gates[:, :, 2] * (yc @ w_c_out[l]))
        x = x + g1 * rms_norm(merged @ w_o[l], mix_norm_post[l])

        h = rms_norm(x, mlp_norm_pre[l]) * (1.0 + sc2) + sh2
        y = jnp.square(jax.nn.relu(h @ w_up[l])) @ w_down[l]
        x = x + g2 * rms_norm(y, mlp_norm_post[l])
    return x
```

```cpp
#include <hip/hip_runtime.h>
#include <cstdio>
#include <cstdint>

#ifndef PROBE_PHASE
#define PROBE_PHASE -1
#endif
#ifndef MK_ONE_LAUNCH
#define MK_ONE_LAUNCH 1
#endif

namespace pg8 {
#define PG8_LAS __attribute__((address_space(3)))
typedef unsigned short bf16_t;
typedef short bf16x8 __attribute__((ext_vector_type(8)));
typedef float f32x4 __attribute__((ext_vector_type(4)));
typedef unsigned u32x4 __attribute__((ext_vector_type(4)));
constexpr int BM = 256, BK = 64, HALF = 128, HTB = HALF * BK * 2, STAGE_BYTES = 8 * HTB, NXCD = 8, WGM = 8;

__host__ __device__ __forceinline__ int lds_byte(int r, int c) { const int st = (r >> 4) * 2 + (c >> 5), rr = r & 15, cc = c & 31, ob = rr * 64 + cc * 2; return st * 1024 + (ob ^ (((ob >> 9) & 1) << 5)); }
__host__ __device__ __forceinline__ void stage_rc(int b, int& R, int& C) { const int st = b / 1024, sb = b % 1024, swz = sb ^ (((sb >> 9) & 1) << 5); R = (st >> 1) * 16 + swz / 64; C = (st & 1) * 32 + (swz % 64) / 2; }
__host__ __device__ __forceinline__ int perm32(int rho) { const int n = rho >> 4, i = rho & 15; return 8 * (i >> 2) + 4 * n + (i & 3); }

struct Unit { int pm, pn, koff, nt, seg; };
struct Gemm { const bf16_t* A; const bf16_t* Bt; int lda, ldb; };

__device__ __forceinline__ void tile_of(int L, int nM, int nN, int& pm, int& pn) {
    const int nwg = nM * nN; int wgid = L;
    { const int q = nwg / NXCD, r = nwg % NXCD, xcd = wgid % NXCD, off = wgid / NXCD; wgid = (xcd < r ? xcd * (q + 1) : r * (q + 1) + (xcd - r) * q) + off; }
    const int nig = WGM * nN, gid = wgid / nig, fm = gid * WGM, gsz = (nM - fm) < WGM ? (nM - fm) : WGM;
    pm = fm + ((wgid % nig) % gsz); pn = (wgid % nig) / gsz;
}
struct StaticOrder {
    int nM, nN, nwg, G, c, nt;
    __device__ void init(int M, int N, int K, int G_, int c_) { nM = M / BM; nN = N / BM; nwg = nM * nN; G = G_; c = c_; nt = K / BK; }
    __device__ bool next(int i, Unit& u) const {
        const long L = (long)i * G + c; if (L >= nwg) return false;
        tile_of((int)L, nM, nN, u.pm, u.pn); u.koff = 0; u.nt = nt; u.seg = 0; return true;
    }
};
struct SegOrder3 {
    int nM, nN, nwg, G, c;
    __device__ void init(int M, int N, int G_, int c_) { nM = M / BM; nN = N / BM; nwg = nM * nN; G = G_; c = c_; }
    __device__ bool next(int i, Unit& u) const {
        const int ti = i / 3, seg = i - ti * 3; const long L = (long)ti * G + c; if (L >= nwg) return false;
        tile_of((int)L, nM, nN, u.pm, u.pn); u.seg = seg;
        u.koff = seg == 0 ? 0 : (seg == 1 ? 1024 : 1280); u.nt = seg == 0 ? 16 : (seg == 1 ? 4 : 12); return true;
    }
};

typedef __bf16 bf16x2_t __attribute__((ext_vector_type(2)));
__device__ __forceinline__ unsigned cvt_pk_bf16(float lo, float hi) { bf16x2_t v; v[0] = (__bf16)lo; v[1] = (__bf16)hi; return __builtin_bit_cast(unsigned, v); }
__device__ __forceinline__ float bf_lo(unsigned w) { return __uint_as_float(w << 16); }
__device__ __forceinline__ float bf_hi(unsigned w) { return __uint_as_float(w & 0xffff0000u); }
__device__ __forceinline__ float sigmoidf_fast(float x) { return __builtin_amdgcn_rcpf(1.0f + __expf(-x)); }

struct EpiF32 {
    static constexpr bool PERM = false, KEEP_ACC = false;
    float* C; int ldc;
    __device__ __forceinline__ void operator()(const f32x4 (&acc)[2][2][4][2], const Unit& u, int wr, int wc, int fr, int fq) const {
        const int row0 = u.pm * BM + wr * 64 + fr, col0 = u.pn * BM + wc * 32 + 4 * fq;
#pragma unroll
        for (int ai = 0; ai < 2; ++ai)
#pragma unroll
            for (int m = 0; m < 4; ++m) { float* rowp = C + (size_t)(row0 + ai * HALF + m * 16) * ldc + col0;
#pragma unroll
                for (int bj = 0; bj < 2; ++bj)
#pragma unroll
                    for (int n = 0; n < 2; ++n) *(f32x4*)(rowp + bj * HALF + n * 16) = acc[ai][bj][m][n]; }
    }
};
struct EpiBf16 {
    static constexpr bool PERM = true, KEEP_ACC = false;
    bf16_t* O; int ldc;
    __device__ __forceinline__ void operator()(const f32x4 (&acc)[2][2][4][2], const Unit& u, int wr, int wc, int fr, int fq) const {
        const int row0 = u.pm * BM + wr * 64 + fr, col0 = u.pn * BM + wc * 32 + 8 * fq;
#pragma unroll
        for (int ai = 0; ai < 2; ++ai)
#pragma unroll
            for (int m = 0; m < 4; ++m) { bf16_t* rowp = O + (size_t)(row0 + ai * HALF + m * 16) * ldc + col0;
#pragma unroll
                for (int bj = 0; bj < 2; ++bj) { const f32x4 v0 = acc[ai][bj][m][0], v1 = acc[ai][bj][m][1];
                    u32x4 w; w.x = cvt_pk_bf16(v0[0], v0[1]); w.y = cvt_pk_bf16(v0[2], v0[3]); w.z = cvt_pk_bf16(v1[0], v1[1]); w.w = cvt_pk_bf16(v1[2], v1[3]);
                    *(u32x4*)(rowp + bj * HALF) = w; } }
    }
};
struct EpiInGate {
    static constexpr bool PERM = true, KEEP_ACC = false;
    bf16_t* INP; bf16_t* GATES; const float* bgate;
    __device__ __forceinline__ void operator()(const f32x4 (&acc)[2][2][4][2], const Unit& u, int wr, int wc, int fr, int fq) const {
        const int row0 = u.pm * BM + wr * 64 + fr; const bool gate = u.pn >= 31;
        const int colt = (gate ? (u.pn - 31) : u.pn) * BM, ldc = gate ? 6144 : 7936; bf16_t* base = gate ? GATES : INP;
        const int col0 = colt + wc * 32 + 8 * fq;
        f32x4 bv[2][2];
#pragma unroll
        for (int bj = 0; bj < 2; ++bj)
#pragma unroll
            for (int n = 0; n < 2; ++n) bv[bj][n] = gate ? *(const f32x4*)(bgate + col0 + bj * HALF + 4 * n) : (f32x4){0.f, 0.f, 0.f, 0.f};
        if (u.pn >= 25 && u.pn < 31) {
            bf16_t* ub = INP + (size_t)row0 * 7936 + 6400 + (u.pn - 25) * 128 + wc * 32 + 8 * fq;
#pragma unroll
            for (int ai = 0; ai < 2; ++ai)
#pragma unroll
                for (int m = 0; m < 4; ++m) { f32x4 v0 = acc[ai][0][m][0], v1 = acc[ai][0][m][1]; const f32x4 g0 = acc[ai][1][m][0], g1 = acc[ai][1][m][1];
#pragma unroll
                    for (int j = 0; j < 4; ++j) { v0[j] *= sigmoidf_fast(g0[j]); v1[j] *= sigmoidf_fast(g1[j]); }
                    u32x4 w; w.x = cvt_pk_bf16(v0[0], v0[1]); w.y = cvt_pk_bf16(v0[2], v0[3]); w.z = cvt_pk_bf16(v1[0], v1[1]); w.w = cvt_pk_bf16(v1[2], v1[3]);
                    *(u32x4*)(ub + (size_t)(ai * HALF + m * 16) * 7936) = w; }
            return;
        }
        const int hact = (u.pn < 4 || (u.pn >= 12 && u.pn < 16)) ? 1 : ((u.pn >= 4 && u.pn < 8) ? 2 : 0);
#pragma unroll
        for (int ai = 0; ai < 2; ++ai)
#pragma unroll
            for (int m = 0; m < 4; ++m) { bf16_t* rowp = base + (size_t)(row0 + ai * HALF + m * 16) * ldc + col0;
#pragma unroll
                for (int bj = 0; bj < 2; ++bj) { f32x4 v0 = acc[ai][bj][m][0] + bv[bj][0], v1 = acc[ai][bj][m][1] + bv[bj][1];
                    if (hact == 1) {
#pragma unroll
                        for (int j = 0; j < 4; ++j) { v0[j] *= sigmoidf_fast(v0[j]); v1[j] *= sigmoidf_fast(v1[j]); } }
                    if (hact == 2) {
#pragma unroll
                        for (int j = 0; j < 4; ++j) { v0[j] = sigmoidf_fast(-v0[j]); v1[j] = sigmoidf_fast(-v1[j]); } }
                    if (gate) {
#pragma unroll
                        for (int j = 0; j < 4; ++j) { v0[j] = fmaxf(sigmoidf_fast(v0[j]), 1e-20f); v1[j] = fmaxf(sigmoidf_fast(v1[j]), 1e-20f); } }
                    u32x4 w; w.x = cvt_pk_bf16(v0[0], v0[1]); w.y = cvt_pk_bf16(v0[2], v0[3]); w.z = cvt_pk_bf16(v1[0], v1[1]); w.w = cvt_pk_bf16(v1[2], v1[3]);
                    *(u32x4*)(rowp + bj * HALF) = w; } }
    }
};
struct EpiRelu2 {
    static constexpr bool PERM = true, KEEP_ACC = false;
    bf16_t* O; int ldc;
    __device__ __forceinline__ void operator()(const f32x4 (&acc)[2][2][4][2], const Unit& u, int wr, int wc, int fr, int fq) const {
        const int row0 = u.pm * BM + wr * 64 + fr, col0 = u.pn * BM + wc * 32 + 8 * fq;
#pragma unroll
        for (int ai = 0; ai < 2; ++ai)
#pragma unroll
            for (int m = 0; m < 4; ++m) { bf16_t* rowp = O + (size_t)(row0 + ai * HALF + m * 16) * ldc + col0;
#pragma unroll
                for (int bj = 0; bj < 2; ++bj) { f32x4 v0 = acc[ai][bj][m][0], v1 = acc[ai][bj][m][1];
#pragma unroll
                    for (int j = 0; j < 4; ++j) { const float a = fmaxf(v0[j], 0.f), b = fmaxf(v1[j], 0.f); v0[j] = a * a; v1[j] = b * b; }
                    u32x4 w; w.x = cvt_pk_bf16(v0[0], v0[1]); w.y = cvt_pk_bf16(v0[2], v0[3]); w.z = cvt_pk_bf16(v1[0], v1[1]); w.w = cvt_pk_bf16(v1[2], v1[3]);
                    *(u32x4*)(rowp + bj * HALF) = w; } }
    }
};
struct EpiMerge {
    static constexpr bool PERM = true, KEEP_ACC = true;
    bf16_t* MERGED; const bf16_t* GATES;
    __device__ __forceinline__ void operator()(f32x4 (&acc)[2][2][4][2], const Unit& u, int wr, int wc, int fr, int fq) const {
        const int row0 = u.pm * BM + wr * 64 + fr, col0 = u.pn * BM + wc * 32 + 8 * fq; const int seg = u.seg;
#pragma unroll
        for (int ai = 0; ai < 2; ++ai)
#pragma unroll
            for (int m = 0; m < 4; ++m) { const size_t row = (size_t)(row0 + ai * HALF + m * 16);
#pragma unroll
                for (int bj = 0; bj < 2; ++bj) {
                    const bf16_t* gp = GATES + row * 6144 + col0 + bj * HALF;
                    f32x4& a0 = acc[ai][bj][m][0]; f32x4& a1 = acc[ai][bj][m][1];
                    if (seg != 2) {
                        const u32x4 gn = *(const u32x4*)(gp + seg * 2048), gd = *(const u32x4*)(gp + (seg + 1) * 2048);
                        a0[0] *= bf_lo(gn.x) * __builtin_amdgcn_rcpf(bf_lo(gd.x)); a0[1] *= bf_hi(gn.x) * __builtin_amdgcn_rcpf(bf_hi(gd.x));
                        a0[2] *= bf_lo(gn.y) * __builtin_amdgcn_rcpf(bf_lo(gd.y)); a0[3] *= bf_hi(gn.y) * __builtin_amdgcn_rcpf(bf_hi(gd.y));
                        a1[0] *= bf_lo(gn.z) * __builtin_amdgcn_rcpf(bf_lo(gd.z)); a1[1] *= bf_hi(gn.z) * __builtin_amdgcn_rcpf(bf_hi(gd.z));
                        a1[2] *= bf_lo(gn.w) * __builtin_amdgcn_rcpf(bf_lo(gd.w)); a1[3] *= bf_hi(gn.w) * __builtin_amdgcn_rcpf(bf_hi(gd.w));
                    } else {
                        const u32x4 g = *(const u32x4*)(gp + 2 * 2048);
                        u32x4 w; w.x = cvt_pk_bf16(a0[0] * bf_lo(g.x), a0[1] * bf_hi(g.x)); w.y = cvt_pk_bf16(a0[2] * bf_lo(g.y), a0[3] * bf_hi(g.y));
                        w.z = cvt_pk_bf16(a1[0] * bf_lo(g.z), a1[1] * bf_hi(g.z)); w.w = cvt_pk_bf16(a1[2] * bf_lo(g.w), a1[3] * bf_hi(g.w));
                        *(u32x4*)(MERGED + row * 2048 + col0 + bj * HALF) = w; } } }
    }
};

template <class Epi, class Sched, bool ALIGN_EPI = true>
__device__ __forceinline__ void gemm_phase(PG8_LAS unsigned char* lds, const Gemm g, const Sched& S, const Epi& E) {
    const int tid = threadIdx.x, wid = __builtin_amdgcn_readfirstlane(tid >> 6), lane = tid & 63, wr = wid >> 2, wc = wid & 3, fr = lane & 15, fq = lane >> 4;
    unsigned voffA[2], voffB[2];
#pragma unroll
    for (int i = 0; i < 2; ++i) { int R, C; stage_rc(tid * 16 + i * 8192, R, C); const int Rb = Epi::PERM ? ((R & ~31) + perm32(R & 31)) : R;
        voffA[i] = (unsigned)(R * g.lda + C) * 2u; voffB[i] = (unsigned)(Rb * g.ldb + C) * 2u; }
    const size_t kstep = (size_t)(BK * 2);
    const size_t hstepA = (size_t)HALF * g.lda * 2, hstepB = (size_t)HALF * g.ldb * 2;
    const size_t tstepA = 2 * hstepA, tstepB = 2 * hstepB;
    const unsigned ldsw = (unsigned)wid * 1024u;
    const int aoff = lds_byte(wr * 64 + fr, fq * 8), boff = lds_byte(wc * 32 + fr, fq * 8);
#define PG8_SA(b, h) (((b) * 2 + (h)) * HTB)
#define PG8_SB(b, h) ((4 + (b) * 2 + (h)) * HTB)
#define PG8_STAGE(bufoff, gbase, voff) do { _Pragma("unroll") for (int _i = 0; _i < 2; ++_i) \
        __builtin_amdgcn_global_load_lds((const unsigned*)((const char*)(gbase) + (voff)[_i]), (PG8_LAS unsigned*)(lds + (bufoff) + ldsw + _i * 8192), 16, 0, 0); } while (0)
#define PG8_LDA(dst, b, h) do { _Pragma("unroll") for (int m = 0; m < 4; ++m) _Pragma("unroll") for (int k = 0; k < 2; ++k) dst[m][k] = *(const PG8_LAS bf16x8*)(lds + PG8_SA(b, h) + aoff + m * 2048 + k * 1024); } while (0)
#define PG8_LDB(dst, b, h) do { _Pragma("unroll") for (int n = 0; n < 2; ++n) _Pragma("unroll") for (int k = 0; k < 2; ++k) dst[n][k] = *(const PG8_LAS bf16x8*)(lds + PG8_SB(b, h) + boff + n * 2048 + k * 1024); } while (0)
#define PG8_MMA(ai, bj, At, Bt) do { __builtin_amdgcn_s_setprio(1); _Pragma("unroll") for (int m = 0; m < 4; ++m) _Pragma("unroll") for (int n = 0; n < 2; ++n) _Pragma("unroll") for (int k = 0; k < 2; ++k) \
        acc[ai][bj][m][n] = __builtin_amdgcn_mfma_f32_16x16x32_bf16(Bt[n][k], At[m][k], acc[ai][bj][m][n], 0, 0, 0); __builtin_amdgcn_s_setprio(0); } while (0)
#define PG8_WAIT_V(n) asm volatile("s_waitcnt vmcnt(" #n ")" ::: "memory")
#define PG8_WAIT_L(n) asm volatile("s_waitcnt lgkmcnt(" #n ")" ::: "memory")
#define PG8_BAR __builtin_amdgcn_s_barrier()
#define PG8_SCHED __builtin_amdgcn_sched_barrier(0)
    Unit cur, nxt; int ui = 0;
    if (!S.next(0, cur)) return;
    f32x4 acc[2][2][4][2];
#pragma unroll
    for (int a = 0; a < 2; ++a)
#pragma unroll
        for (int b = 0; b < 2; ++b)
#pragma unroll
            for (int m = 0; m < 4; ++m)
#pragma unroll
                for (int n = 0; n < 2; ++n) acc[a][b][m][n] = (f32x4){0.f, 0.f, 0.f, 0.f};
    bf16x8 At[4][2], B0[2][2], B1[2][2];
    const char* cA = (const char*)g.A + (size_t)cur.pm * tstepA + (size_t)cur.koff * 2; const char* cB = (const char*)g.Bt + (size_t)cur.pn * tstepB + (size_t)cur.koff * 2;
    PG8_STAGE(PG8_SB(0, 0), cB, voffB); PG8_STAGE(PG8_SB(0, 1), cB + hstepB, voffB); PG8_STAGE(PG8_SA(0, 0), cA, voffA); PG8_STAGE(PG8_SA(0, 1), cA + hstepA, voffA);
    if (wr == 1) PG8_BAR;
    PG8_WAIT_V(2); PG8_BAR;
    PG8_STAGE(PG8_SB(1, 0), cB + kstep, voffB); PG8_STAGE(PG8_SA(1, 0), cA + kstep, voffA); PG8_STAGE(PG8_SB(1, 1), cB + hstepB + kstep, voffB);
    PG8_WAIT_V(6); PG8_BAR;
    for (;;) {
        const bool has_next = S.next(ui + 1, nxt);
        const char* nA = has_next ? (const char*)g.A + (size_t)nxt.pm * tstepA + (size_t)nxt.koff * 2 : cA;
        const char* nB = has_next ? (const char*)g.Bt + (size_t)nxt.pn * tstepB + (size_t)nxt.koff * 2 : cB;
        const int nt = cur.nt;
        for (int t = 0; t < nt; t += 2) {
            const bool last = (t == nt - 2);
            const char* a1 = cA + (size_t)(t + 1) * kstep;
            const char* a2 = last ? nA : cA + (size_t)(t + 2) * kstep; const char* b2 = last ? nB : cB + (size_t)(t + 2) * kstep;
            const char* a3 = a2 + kstep; const char* b3 = b2 + kstep;
            PG8_LDB(B0, 0, 0); PG8_LDB(B1, 0, 1); PG8_SCHED; PG8_LDA(At, 0, 0); PG8_STAGE(PG8_SA(1, 1), a1 + hstepA, voffA);
            PG8_WAIT_V(8); PG8_WAIT_L(0); PG8_BAR; PG8_MMA(0, 0, At, B0); PG8_MMA(0, 1, At, B1); PG8_BAR; PG8_SCHED;
            PG8_LDA(At, 0, 1); PG8_STAGE(PG8_SB(0, 0), b2, voffB); PG8_STAGE(PG8_SB(0, 1), b2 + hstepB, voffB); PG8_STAGE(PG8_SA(0, 0), a2, voffA);
            PG8_WAIT_V(8); PG8_WAIT_L(0); PG8_BAR; PG8_MMA(1, 0, At, B0); PG8_MMA(1, 1, At, B1); PG8_BAR; PG8_SCHED;
            PG8_LDB(B0, 1, 0); PG8_LDB(B1, 1, 1); PG8_SCHED; PG8_LDA(At, 1, 0); PG8_STAGE(PG8_SA(0, 1), a2 + hstepA, voffA);
            PG8_WAIT_V(8); PG8_WAIT_L(0); PG8_BAR; PG8_MMA(0, 0, At, B0); PG8_MMA(0, 1, At, B1); PG8_BAR; PG8_SCHED;
            PG8_LDA(At, 1, 1); PG8_STAGE(PG8_SB(1, 0), b3, voffB); PG8_STAGE(PG8_SB(1, 1), b3 + hstepB, voffB); PG8_STAGE(PG8_SA(1, 0), a3, voffA);
            PG8_WAIT_V(8); PG8_WAIT_L(0); PG8_BAR; PG8_MMA(1, 0, At, B0); PG8_MMA(1, 1, At, B1); PG8_BAR; PG8_SCHED;
        }
        if constexpr (ALIGN_EPI) { if (wr == 0) PG8_BAR; }
        E(acc, cur, wr, wc, fr, fq);
        if (!has_next) break;
        if (!(Epi::KEEP_ACC && nxt.seg != 0)) {
#pragma unroll
        for (int a = 0; a < 2; ++a)
#pragma unroll
            for (int b = 0; b < 2; ++b)
#pragma unroll
                for (int m = 0; m < 4; ++m)
#pragma unroll
                    for (int n = 0; n < 2; ++n) acc[a][b][m][n] = (f32x4){0.f, 0.f, 0.f, 0.f};
        }
        cur = nxt; cA = nA; cB = nB; ++ui;
        if constexpr (ALIGN_EPI) { if (wr == 1) PG8_BAR; }
    }
    PG8_WAIT_V(0);
    if constexpr (!ALIGN_EPI) { if (wr == 0) PG8_BAR; }
    PG8_BAR;
#undef PG8_SA
#undef PG8_SB
#undef PG8_STAGE
#undef PG8_LDA
#undef PG8_LDB
#undef PG8_MMA
#undef PG8_WAIT_V
#undef PG8_WAIT_L
#undef PG8_BAR
#undef PG8_SCHED
}
}

constexpr int NWAVES = 8, NTHREADS = 512;
constexpr int DM = 2048, NB = 4, SEQ = 2048, M = NB * SEQ, DEPTH = 2, DFF = 8192;
constexpr int NIN = 7936, NGATE = 6144, N1 = NIN + NGATE;
constexpr int OFF_AQ = 0, OFF_AF = 1024, OFF_AI = 2048, OFF_AG = 3072, OFF_BQ = 4096, OFF_BK = 4864, OFF_BV = 5632, OFF_CA = 6400, OFF_CG = 7168;
constexpr int YC_A = 0, YC_B = 1024, YC_C = 1280;
constexpr float EPS = 1e-6f;

constexpr size_t MiB = 1u << 20;
constexpr size_t WS_CTL = 0, CTL_ZERO_BYTES = 1 * MiB;
constexpr size_t WS_MOD = 1 * MiB;
constexpr size_t WS_LB = WS_MOD + 512 * 1024;
constexpr size_t WS_BIAS = WS_LB + 16 * 1024;
constexpr size_t WS_W = 2 * MiB, W_LAYER = 135 * MiB;
constexpr size_t WO_CAT1 = 0, WO_CAT2 = 55 * MiB, WO_O = 63 * MiB, WO_UP = 71 * MiB, WO_DOWN = 103 * MiB;
constexpr size_t WS_H = 272 * MiB;
constexpr size_t WS_INP = 304 * MiB;
constexpr size_t WS_GATES = 428 * MiB;
constexpr size_t WS_U = WS_INP;
constexpr size_t WS_YCAT = 524 * MiB;
constexpr size_t WS_MPART = 556 * MiB;
constexpr size_t WS_Y = WS_MPART;
constexpr size_t WS_MERGED = 620 * MiB;
constexpr size_t WS_ATTO = 652 * MiB;
constexpr size_t WS_ATTL = 676 * MiB;
constexpr size_t WS_HDEC = 676 * MiB + 512 * 1024;
constexpr size_t WS_HSTATE = WS_MPART;
constexpr size_t WS_END = 677 * MiB;

constexpr int G1_GEMM_CUS = 220;
constexpr int LDS_BYTES = 147456;
constexpr int RING_OFF = 0, MISC_OFF = LDS_BYTES - 256;

#define GAS __attribute__((address_space(1)))
#define LAS __attribute__((address_space(3)))
typedef unsigned short bf16;
typedef unsigned v4u __attribute__((ext_vector_type(4)));
typedef unsigned v2u __attribute__((ext_vector_type(2)));
typedef float f32x4 __attribute__((ext_vector_type(4)));
typedef float f32x2 __attribute__((ext_vector_type(2)));
typedef GAS unsigned gu32;
#define RLX_AGENT __ATOMIC_RELAXED, __HIP_MEMORY_SCOPE_AGENT
#define LDS_WAIT() asm volatile("s_waitcnt lgkmcnt(0)" ::: "memory")
__device__ __forceinline__ unsigned f2bf(float f) { unsigned u = __builtin_bit_cast(unsigned, f); return (u + 0x7fffu + ((u >> 16) & 1u)) >> 16; }
typedef __bf16 bf16x2_t __attribute__((ext_vector_type(2)));
__device__ __forceinline__ unsigned pk2(float lo, float hi) { bf16x2_t v; v[0] = (__bf16)lo; v[1] = (__bf16)hi; return __builtin_bit_cast(unsigned, v); }
__device__ __forceinline__ float bf2f(bf16 b) { return __uint_as_float(((unsigned)b) << 16); }
__device__ __forceinline__ float bflo(unsigned w) { return __uint_as_float(w << 16); }
__device__ __forceinline__ float bfhi(unsigned w) { return __uint_as_float(w & 0xffff0000u); }
__device__ __forceinline__ float sigm(float x) { return __builtin_amdgcn_rcpf(1.0f + __expf(-x)); }

#define XB_TMO      128
#define XB_XCNT(j)  (256  + 64 * (j))
#define XB_XSUB(j)  (1280 + 64 * (j))
#define XB_XGEN(j)  (2304 + 64 * (j))
#define XB_TOP      3328
#define XB_TOPGEN   3392
#define XCD_BAR_WORDS 3456
#define XB_SPIN_CAP (1u << 22)
__device__ __forceinline__ unsigned xb_ld(unsigned* p)              { return __hip_atomic_load(p, __ATOMIC_RELAXED, __HIP_MEMORY_SCOPE_AGENT); }
__device__ __forceinline__ unsigned xb_add(unsigned* p, unsigned v) { return __hip_atomic_fetch_add(p, v, __ATOMIC_RELAXED, __HIP_MEMORY_SCOPE_AGENT); }
__device__ __forceinline__ unsigned xb_xcc_id() { return (unsigned)__builtin_amdgcn_s_getreg((3 << 11) | 20) & 0xFu; }
#define XB_SPIN(cond, bar) do { unsigned _sp = 0; while (cond) { __builtin_amdgcn_s_sleep(1); \
    if ((++_sp & 255u) == 0u) { if (xb_ld(&(bar)[XB_TMO])) break; if (_sp > XB_SPIN_CAP) { atomicAdd(&(bar)[XB_TMO], 1u); break; } } } } while (0)
struct XcdBarrier { unsigned* bar; unsigned x; volatile LAS unsigned* st; };
__device__ __forceinline__ XcdBarrier xcd_barrier_post(unsigned* bar, volatile LAS unsigned* st) {
    XcdBarrier b; b.bar = bar; b.x = xb_xcc_id(); b.st = st;
    if (threadIdx.x == 0) (void)xb_add(&bar[XB_XCNT(b.x)], 1u);
    return b;
}
__device__ __forceinline__ void xcd_barrier_complete(unsigned* bar, unsigned x, unsigned& nloc, unsigned& nx) {
    const unsigned G = gridDim.x * gridDim.y * gridDim.z;
    unsigned sum, cnt, mine, sp = 0u;
    for (;;) {
        sum = 0u; cnt = 0u; mine = 0u;
#pragma unroll
        for (unsigned j = 0; j < 16; ++j) { const unsigned c = xb_ld(&bar[XB_XCNT(j)]); sum += c; cnt += (c > 0u) ? 1u : 0u; mine = (j == x) ? c : mine; }
        if (sum == G) break;
        __builtin_amdgcn_s_sleep(1);
        if ((++sp & 255u) == 0u) { if (xb_ld(&bar[XB_TMO])) break; if (sp > XB_SPIN_CAP) { atomicAdd(&bar[XB_TMO], 1u); break; } }
    }
    nloc = mine > 0u ? mine : 1u; nx = cnt > 0u ? cnt : 1u;
}
__device__ __forceinline__ void xcd_barrier(const XcdBarrier& b) {
    asm volatile("s_waitcnt vmcnt(0)" ::: "memory");
    __syncthreads();
    if (threadIdx.x == 0) {
        unsigned* bar = b.bar;
        __builtin_amdgcn_s_waitcnt(0);
        unsigned nloc = b.st[0], nx = b.st[1];
        if (nloc == 0u) { xcd_barrier_complete(bar, b.x, nloc, nx); b.st[0] = nloc; b.st[1] = nx; }
        const unsigned old = xb_add(&bar[XB_XSUB(b.x)], 1u);
        const unsigned gen = old / nloc;
        if (old + 1u == (gen + 1u) * nloc) {
            __builtin_amdgcn_fence(__ATOMIC_RELEASE, "agent");
            asm volatile("s_waitcnt vmcnt(0)" ::: "memory");
            const unsigned og = xb_add(&bar[XB_TOP], 1u);
            const unsigned tg = og / nx;
            if (og + 1u == (tg + 1u) * nx) xb_add(&bar[XB_TOPGEN], 1u);
            else XB_SPIN(xb_ld(&bar[XB_TOPGEN]) == tg, bar);
            __builtin_amdgcn_fence(__ATOMIC_ACQUIRE, "agent");
            xb_add(&bar[XB_XGEN(b.x)], 1u);
            asm volatile("s_waitcnt vmcnt(0)" ::: "memory");
        } else {
            XB_SPIN(xb_ld(&bar[XB_XGEN(b.x)]) == gen, bar);
            __builtin_amdgcn_fence(__ATOMIC_ACQUIRE, "agent");
            asm volatile("s_waitcnt vmcnt(0)" ::: "memory");
        }
    }
    __syncthreads();
}

struct Args { const float* in[24]; float* out; unsigned char* ws; int ph_lo, ph_hi; };
enum { IN_X = 0, IN_C, IN_RELB, IN_LBL, IN_WADA, IN_BADA, IN_NPRE, IN_NPOST, IN_WIN, IN_WGATE, IN_BGATE, IN_HNW, IN_CW, IN_CB, IN_CLG, IN_CLB,
       IN_WA, IN_WB, IN_WC, IN_WO, IN_MPRE, IN_MPOST, IN_WUP, IN_WDOWN };

struct Frame {
    LAS unsigned char* lds;
    int tid, lane, wave, G, bid;
    const Args* a;
    unsigned char* ws;
};

__device__ __forceinline__ float dpp_add(float v, const int ctrl_sel) {
    int x;
    if (ctrl_sel == 0) x = __builtin_amdgcn_update_dpp(0, __float_as_int(v), 0xB1, 0xf, 0xf, false);
    else if (ctrl_sel == 1) x = __builtin_amdgcn_update_dpp(0, __float_as_int(v), 0x4E, 0xf, 0xf, false);
    else if (ctrl_sel == 2) x = __builtin_amdgcn_update_dpp(0, __float_as_int(v), 0x141, 0xf, 0xf, false);
    else x = __builtin_amdgcn_update_dpp(0, __float_as_int(v), 0x140, 0xf, 0xf, false);
    return v + __int_as_float(x);
}
__device__ __forceinline__ float wave_sum(float v) {
    v = dpp_add(v, 0); v = dpp_add(v, 1); v = dpp_add(v, 2); v = dpp_add(v, 3);
    const float s0 = __int_as_float(__builtin_amdgcn_readlane(__float_as_int(v), 0)), s1 = __int_as_float(__builtin_amdgcn_readlane(__float_as_int(v), 16));
    const float s2 = __int_as_float(__builtin_amdgcn_readlane(__float_as_int(v), 32)), s3 = __int_as_float(__builtin_amdgcn_readlane(__float_as_int(v), 48));
    return (s0 + s1) + (s2 + s3);
}

struct TrItem { const float* src; bf16* dst; int N, ldt; };
__device__ __forceinline__ void tr_load(const TrItem& t, f32x4 (&v)[16], int lane) {
    const float* src = t.src + (size_t)(16 * (lane >> 4)) * t.N + 4 * (lane & 15);
#pragma unroll
    for (int i = 0; i < 16; ++i) v[i] = __builtin_nontemporal_load((const GAS f32x4*)(src + (size_t)i * t.N));
}
__device__ __forceinline__ void tr_finish(const TrItem& t, const f32x4 (&v)[16], LAS unsigned char* scr, int lane) {
    const int q = lane >> 4, p = lane & 15;
#pragma unroll
    for (int c = 0; c < 4; ++c) {
        v4u lo, hi;
        lo.x = pk2(v[0][c], v[1][c]); lo.y = pk2(v[2][c], v[3][c]); lo.z = pk2(v[4][c], v[5][c]); lo.w = pk2(v[6][c], v[7][c]);
        hi.x = pk2(v[8][c], v[9][c]); hi.y = pk2(v[10][c], v[11][c]); hi.z = pk2(v[12][c], v[13][c]); hi.w = pk2(v[14][c], v[15][c]);
        LAS unsigned char* d = scr + (4 * p + c) * 144 + q * 32;
        *(LAS v4u*)d = lo; *(LAS v4u*)(d + 16) = hi; }
    LDS_WAIT(); asm volatile("" ::: "memory");
#pragma unroll
    for (int j = 0; j < 8; ++j) { const int n = (lane >> 3) + 8 * j, ch = lane & 7;
        const v4u o = *(const LAS v4u*)(scr + n * 144 + ch * 16);
        *(GAS v4u*)(t.dst + (size_t)n * t.ldt + 8 * ch) = o; }
    LDS_WAIT(); asm volatile("" ::: "memory");
}

constexpr int TR_IN = 32 * 124, TR_GATE = 32 * 96, TR_A = 16 * 32, TR_B = 4 * 32, TR_C = 12 * 32, TR_O = 32 * 32, TR_UP = 32 * 128, TR_DOWN = 128 * 32;
constexpr int TR_PER_LAYER = TR_IN + TR_GATE + TR_A + TR_B + TR_C + TR_O + TR_UP + TR_DOWN, TR_FIRST = TR_IN + TR_GATE;
constexpr int PREP_ITEMS = (G1_GEMM_CUS < 256) ? TR_FIRST : 2 * TR_PER_LAYER;
__device__ __forceinline__ TrItem tr_decode(Frame& F, int it) {
    const Args& A = *F.a;
    const int l = it / TR_PER_LAYER; int r = it % TR_PER_LAYER;
    unsigned char* wl = F.ws + WS_W + (size_t)l * W_LAYER;
    const float* W; int N, ldt, row_off = 0, col_off = 0; bf16* WT;
    if (r < TR_IN) { W = A.in[IN_WIN] + (size_t)l * 2048 * NIN; N = NIN; WT = (bf16*)(wl + WO_CAT1); ldt = 2048; }
    else if ((r -= TR_IN) < TR_GATE) { W = A.in[IN_WGATE] + (size_t)l * 2048 * NGATE; N = NGATE; WT = (bf16*)(wl + WO_CAT1); ldt = 2048; row_off = NIN; }
    else if ((r -= TR_GATE) < TR_A) { W = A.in[IN_WA] + (size_t)l * 1024 * 2048; N = 2048; WT = (bf16*)(wl + WO_CAT2); ldt = 2048; }
    else if ((r -= TR_A) < TR_B) { W = A.in[IN_WB] + (size_t)l * 256 * 2048; N = 2048; WT = (bf16*)(wl + WO_CAT2); ldt = 2048; col_off = 1024; }
    else if ((r -= TR_B) < TR_C) { W = A.in[IN_WC] + (size_t)l * 768 * 2048; N = 2048; WT = (bf16*)(wl + WO_CAT2); ldt = 2048; col_off = 1280; }
    else if ((r -= TR_C) < TR_O) { W = A.in[IN_WO] + (size_t)l * 2048 * 2048; N = 2048; WT = (bf16*)(wl + WO_O); ldt = 2048; }
    else if ((r -= TR_O) < TR_UP) { W = A.in[IN_WUP] + (size_t)l * 2048 * 8192; N = 8192; WT = (bf16*)(wl + WO_UP); ldt = 2048; }
    else { r -= TR_UP; W = A.in[IN_WDOWN] + (size_t)l * 8192 * 2048; N = 2048; WT = (bf16*)(wl + WO_DOWN); ldt = 8192; }
    const int nblk = N / 64, kb = r / nblk, nb = r % nblk;
    int drow = row_off + 64 * nb;
    if (N == NIN && 64 * nb >= OFF_CA) {
        const int isg = (64 * nb >= OFF_CG) ? 1 : 0, ch = 64 * nb - (isg ? OFF_CG : OFF_CA);
        drow = OFF_CA + 256 * (ch >> 7) + 128 * isg + (ch & 127); }
    TrItem t; t.src = W + (size_t)(64 * kb) * N + 64 * nb; t.dst = WT + (size_t)drow * ldt + col_off + 64 * kb; t.N = N; t.ldt = ldt; return t;
}
__device__ __forceinline__ void transposes(Frame& F, int gw, int ngw, int lo_item, int hi_item) {
    LAS unsigned char* scr = F.lds + F.wave * 16384;
    for (int it = lo_item + gw; it < hi_item; it += 2 * ngw) {
        const bool two = (it + ngw) < hi_item;
        const TrItem t0 = tr_decode(F, it), t1 = tr_decode(F, two ? it + ngw : it);
        f32x4 v0[16], v1[16];
        tr_load(t0, v0, F.lane); if (two) tr_load(t1, v1, F.lane);
        tr_finish(t0, v0, scr, F.lane); if (two) tr_finish(t1, v1, scr, F.lane);
    }
}

__device__ __forceinline__ void gemv_items(Frame& F, int first, int last, int cb, int ncb) {
    const Args& A = *F.a;
    float* MOD = (float*)(F.ws + WS_MOD);
    LAS float* cact = (LAS float*)(F.lds);
    LAS float* red = (LAS float*)(F.lds + 32768);
    __syncthreads();
    for (int e = F.tid; e < 4 * 2048; e += NTHREADS) { const float c = A.in[IN_C][e]; cact[e] = c * sigm(c); }
    __syncthreads();
    for (int it = first + cb; it < last; it += ncb) {
        const int l = it / 384, cg = it % 384, c4 = F.tid & 7, kk = F.tid >> 3;
        const float* W = A.in[IN_WADA] + (size_t)l * 2048 * 12288 + cg * 32 + c4 * 4;
        float acc[4][4];
#pragma unroll
        for (int b = 0; b < 4; ++b)
#pragma unroll
            for (int j = 0; j < 4; ++j) acc[b][j] = 0.f;
#pragma unroll 1
        for (int k0 = kk; k0 < 2048; k0 += 64 * 16) {
            f32x4 wv[16];
#pragma unroll
            for (int u = 0; u < 16; ++u) wv[u] = __builtin_nontemporal_load((const GAS f32x4*)(W + (size_t)(k0 + 64 * u) * 12288));
#pragma unroll
            for (int u = 0; u < 16; ++u) {
#pragma unroll
                for (int b = 0; b < 4; ++b) { const float cv = cact[b * 2048 + k0 + 64 * u];
#pragma unroll
                    for (int j = 0; j < 4; ++j) acc[b][j] += cv * wv[u][j]; } }
        }
#pragma unroll
        for (int b = 0; b < 4; ++b)
#pragma unroll
            for (int j = 0; j < 4; ++j) red[(kk * 8 + c4) * 16 + b * 4 + j] = acc[b][j];
        __syncthreads();
        if (F.tid < 128) { const int b = F.tid >> 5, col = F.tid & 31, cc4 = col >> 2, j = col & 3; float sacc = 0.f;
            for (int q = 0; q < 64; ++q) sacc += red[(q * 8 + cc4) * 16 + b * 4 + j];
            MOD[((size_t)l * 4 + b) * 12288 + cg * 32 + col] = sacc + A.in[IN_BADA][l * 12288 + cg * 32 + col]; }
        __syncthreads();
    }
}
#ifndef GEMV_FIRST_ITEMS
#define GEMV_FIRST_ITEMS 768
#endif
constexpr int GEMV_FIRST = GEMV_FIRST_ITEMS, GEMV_ALL = 768;
__device__ __forceinline__ void prep_phase(Frame& F) {
    const Args& A = *F.a;
    float* LB = (float*)(F.ws + WS_LB); float* BT = (float*)(F.ws + WS_BIAS);
    gemv_items(F, 0, (G1_GEMM_CUS < 256) ? GEMV_FIRST : GEMV_ALL, F.bid, F.G);
    if (F.bid == F.G - 1) {
        for (int k = F.tid; k < 1024; k += NTHREADS) {
            const float a0 = A.in[IN_LBL][k], a1 = A.in[IN_LBL][1024 + k], mx = fmaxf(a0, a1), e0 = expf(a0 - mx), e1 = expf(a1 - mx), s0 = e0 / (e0 + e1), s1 = e1 / (e0 + e1);
            LB[k] = fmaxf(s0 - s0, 0.f); LB[1024 + k] = fmaxf((s0 + s1) - s0, 0.f);
        }
        for (int e = F.tid; e < 3 * 4 * 129; e += NTHREADS) {
            const int g = e / (4 * 129), r = e % (4 * 129), sl = r / 129, j = r % 129; const int dil = g == 0 ? 1 : (g == 1 ? 4 : 16);
            const int dist = j * dil; int bucket;
            if (dist < 16) bucket = dist; else { const float dd = (float)dist; int large = 16 + (int)(logf(dd / 16.0f) / logf(128.0f) * 16.0f); bucket = large < 16 ? 16 : (large > 31 ? 31 : large); }
            BT[(g * 4 + sl) * 132 + j] = A.in[IN_RELB][bucket * 12 + g * 4 + sl];
        }
    }
    __syncthreads();
    transposes(F, F.bid * NWAVES + F.wave, F.G * NWAVES, 0, (F.G > G1_GEMM_CUS) ? PREP_ITEMS : 2 * TR_PER_LAYER);
}

__device__ __forceinline__ void norm_phase(Frame& F, const float* xin, float* xout, const bf16* y, const float* g  , const float* wpost,
                                           const float* wpre, const float* sc, const float* sh, bf16* H) {
    const int gw = F.bid * NWAVES + F.wave, NGW = F.G * NWAVES;
    for (int m0 = 2 * gw; m0 < M; m0 += 2 * NGW) {
        const int b = m0 / SEQ;
        f32x4 v[2][8]; v4u yw[2][4];
#pragma unroll
        for (int r = 0; r < 2; ++r) { const GAS f32x4* xr = (const GAS f32x4*)(xin + (size_t)(m0 + r) * DM) + 2 * F.lane;
#pragma unroll
            for (int j = 0; j < 4; ++j) { v[r][2 * j] = xr[128 * j]; v[r][2 * j + 1] = xr[128 * j + 1]; }
            if (y) { const GAS v4u* yr = (const GAS v4u*)(y + (size_t)(m0 + r) * DM) + F.lane;
#pragma unroll
                for (int j = 0; j < 4; ++j) yw[r][j] = yr[64 * j]; } }
#pragma unroll
        for (int r = 0; r < 2; ++r) {
            const int m = m0 + r;
            if (y) {
                f32x4 yv[8]; float ss = 0.f;
#pragma unroll
                for (int j = 0; j < 4; ++j) { const v4u w = yw[r][j]; yv[2 * j] = (f32x4){bflo(w.x), bfhi(w.x), bflo(w.y), bfhi(w.y)}; yv[2 * j + 1] = (f32x4){bflo(w.z), bfhi(w.z), bflo(w.w), bfhi(w.w)}; }
#pragma unroll
                for (int j = 0; j < 8; ++j) ss += (yv[j].x * yv[j].x + yv[j].y * yv[j].y) + (yv[j].z * yv[j].z + yv[j].w * yv[j].w);
                const float rr = __builtin_amdgcn_rsqf(wave_sum(ss) * (1.0f / DM) + EPS);
#pragma unroll
                for (int j = 0; j < 8; ++j) { const int col = 8 * F.lane + 512 * (j >> 1) + 4 * (j & 1);
                    const f32x4 gg = *(const GAS f32x4*)(g + (size_t)b * 12288 + col), wp = *(const GAS f32x4*)(wpost + col);
                    v[r][j] = v[r][j] + gg * (yv[j] * rr * wp); }
            }
            if (xout) { GAS f32x4* xo = (GAS f32x4*)(xout + (size_t)m * DM) + 2 * F.lane;
#pragma unroll
                for (int j = 0; j < 4; ++j) { xo[128 * j] = v[r][2 * j]; xo[128 * j + 1] = v[r][2 * j + 1]; } }
            if (wpre) {
                float ss = 0.f;
#pragma unroll
                for (int j = 0; j < 8; ++j) ss += (v[r][j].x * v[r][j].x + v[r][j].y * v[r][j].y) + (v[r][j].z * v[r][j].z + v[r][j].w * v[r][j].w);
                const float rr = __builtin_amdgcn_rsqf(wave_sum(ss) * (1.0f / DM) + EPS);
                GAS v4u* ho = (GAS v4u*)(H + (size_t)m * DM) + F.lane;
#pragma unroll
                for (int j = 0; j < 4; ++j) { const int col = 8 * F.lane + 512 * j; v4u o;
                    { const f32x4 wp = *(const GAS f32x4*)(wpre + col), s1 = *(const GAS f32x4*)(sc + (size_t)b * 12288 + col), s0 = *(const GAS f32x4*)(sh + (size_t)b * 12288 + col);
                      const f32x4 h = (v[r][2 * j] * rr * wp) * (s1 + 1.0f) + s0; o.x = pk2(h.x, h.y); o.y = pk2(h.z, h.w); }
                    { const f32x4 wp = *(const GAS f32x4*)(wpre + col + 4), s1 = *(const GAS f32x4*)(sc + (size_t)b * 12288 + col + 4), s0 = *(const GAS f32x4*)(sh + (size_t)b * 12288 + col + 4);
                      const f32x4 h = (v[r][2 * j + 1] * rr * wp) * (s1 + 1.0f) + s0; o.z = pk2(h.x, h.y); o.w = pk2(h.z, h.w); }
                    ho[64 * j] = o; }
            }
        }
    }
}

__device__ __forceinline__ void conv_phase(Frame& F, int l, bf16* YC) {
    const Args& A = *F.a;
    const bf16* INP = (const bf16*)(F.ws + WS_INP);
    const float* CW = A.in[IN_CW] + (size_t)l * 31 * 768; const float* CB = A.in[IN_CB] + l * 768; const float* LG = A.in[IN_CLG] + l * 768; const float* LBt = A.in[IN_CLB] + l * 768;
    LAS float* U = (LAS float*)(F.lds);
    LAS float* red = (LAS float*)(F.lds + 46 * 768 * 4);
    LAS float* fin = red + 6 * 32;
    for (int it = F.bid; it < 512; it += F.G) {
        const int b = it >> 7, t0 = (it & 127) * 16;
        __syncthreads();
#pragma unroll 1
        for (int q0 = 0; q0 < 9; q0 += 3) {
            v4u aw[3];
#pragma unroll
            for (int q = 0; q < 3; ++q) { const int e = F.tid + (q0 + q) * NTHREADS, r = e / 96, c8 = (e - r * 96) * 8, t = t0 - 30 + r;
                aw[q] = (v4u){0u, 0u, 0u, 0u};
                if (e < 46 * 96 && t >= 0) aw[q] = *(const GAS v4u*)(INP + ((size_t)b * SEQ + t) * NIN + OFF_CA + c8); }
#pragma unroll
            for (int q = 0; q < 3; ++q) { const int e = F.tid + (q0 + q) * NTHREADS, r = e / 96, c8 = (e - r * 96) * 8;
                if (e < 46 * 96) { const f32x4 u0 = (f32x4){bflo(aw[q].x), bfhi(aw[q].x), bflo(aw[q].y), bfhi(aw[q].y)}, u1 = (f32x4){bflo(aw[q].z), bfhi(aw[q].z), bflo(aw[q].w), bfhi(aw[q].w)};
                    *(LAS f32x4*)(U + r * 768 + c8) = u0; *(LAS f32x4*)(U + r * 768 + c8 + 4) = u1; } }
        }
        __syncthreads();
        const bool act = F.tid < 384; const int c0 = act ? 2 * F.tid : 0;
        float acc[16][2];
        {
            float w[31][2];
#pragma unroll
            for (int j = 0; j < 31; ++j) { w[j][0] = CW[j * 768 + c0]; w[j][1] = CW[j * 768 + c0 + 1]; }
            const float b0 = CB[c0], b1 = CB[c0 + 1];
#pragma unroll
            for (int tt = 0; tt < 16; ++tt) { acc[tt][0] = b0; acc[tt][1] = b1; }
#pragma unroll
            for (int r = 0; r < 46; ++r) {
                const float u0 = U[r * 768 + c0], u1 = U[r * 768 + c0 + 1];
#pragma unroll
                for (int tt = 0; tt < 16; ++tt) { const int j = r - tt; if (j >= 0 && j <= 30) { acc[tt][0] += u0 * w[j][0]; acc[tt][1] += u1 * w[j][1]; } }
            }
        }
#pragma unroll
        for (int tt = 0; tt < 16; ++tt) {
            float sv = act ? (acc[tt][0] + acc[tt][1]) : 0.f, qv = act ? (acc[tt][0] * acc[tt][0] + acc[tt][1] * acc[tt][1]) : 0.f;
            sv = wave_sum(sv); qv = wave_sum(qv);
            if (F.lane == 0 && F.wave < 6) { red[F.wave * 32 + tt] = sv; red[F.wave * 32 + 16 + tt] = qv; }
        }
        __syncthreads();
        if (F.tid < 16) { float ts = 0.f, tq = 0.f;
#pragma unroll
            for (int w = 0; w < 6; ++w) { ts += red[w * 32 + F.tid]; tq += red[w * 32 + 16 + F.tid]; }
            const float mu = ts * (1.0f / 768.f), var = tq * (1.0f / 768.f) - mu * mu;
            fin[F.tid * 2] = mu; fin[F.tid * 2 + 1] = __builtin_amdgcn_rsqf(var + EPS); }
        __syncthreads();
        if (act) { int c0v = c0; asm volatile("" : "+v"(c0v));
            const float g0 = LG[c0v], g1 = LG[c0v + 1], bb0 = LBt[c0v], bb1 = LBt[c0v + 1];
            GAS unsigned* op = (GAS unsigned*)(YC + ((size_t)b * SEQ + t0) * DM + YC_C + c0v);
#pragma unroll
            for (int tt = 0; tt < 16; ++tt) { const f32x2 mr = *(const LAS f32x2*)(fin + tt * 2);
                const float a0 = (acc[tt][0] - mr.x) * mr.y * g0 + bb0, a1 = (acc[tt][1] - mr.x) * mr.y * g1 + bb1;
                op[tt * (DM / 2)] = pk2(a0 * sigm(a0), a1 * sigm(a1)); } }
    }
}

typedef short s16x4 __attribute__((ext_vector_type(4)));
typedef short s16x8 __attribute__((ext_vector_type(8)));
constexpr int ATT_KS = 144, ATT_VS = 160;
constexpr int ATT_K_OFF = 0, ATT_V_OFF = 256 * ATT_KS, ATT_B_OFF = ATT_V_OFF + 272 * ATT_VS;
typedef short v4i16_t __attribute__((ext_vector_type(4)));
__device__ __forceinline__ s16x4 lds_tr16(LAS unsigned char* p) { return __builtin_bit_cast(s16x4, __builtin_amdgcn_ds_read_tr16_b64_v4i16((LAS v4i16_t*)p)); }
struct AttItem { int g, b, s, r, qb, head, dil; };
__device__ __forceinline__ AttItem att_decode(int it) {
    AttItem a; a.g = it >> 8; const int rem = it & 255; a.b = rem >> 6; a.s = (rem >> 4) & 3; const int rq = rem & 15;
    const int dsh = 2 * a.g, nqbsh = 4 - dsh; a.dil = 1 << dsh;
    a.r = rq >> nqbsh; a.qb = rq & ((1 << nqbsh) - 1); a.head = 4 * a.g + a.s; return a;
}
__device__ __forceinline__ void att_load(Frame& F, const AttItem& a, v4u (&kv)[4], v4u (&vv)[4], v4u (&qv)[2], float& bs) {
    const bf16* INP = (const bf16*)(F.ws + WS_INP); const float* BT = (const float*)(F.ws + WS_BIAS);
#pragma unroll
    for (int i = 0; i < 4; ++i) { const int row = (F.tid >> 3) + 64 * i, ch = F.tid & 7; const int lp = 128 * (a.qb - 1) + row;
        kv[i] = (v4u){0u, 0u, 0u, 0u}; vv[i] = kv[i];
        if (lp >= 0) { const size_t ro = ((size_t)a.b * SEQ + (size_t)lp * a.dil + a.r) * NIN + a.head * 64 + ch * 8;
            kv[i] = *(const GAS v4u*)(INP + ro + OFF_BK); vv[i] = *(const GAS v4u*)(INP + ro + OFF_BV); } }
    const int lq = 128 * a.qb + 16 * F.wave + (F.lane & 15); const size_t qrow = (size_t)a.b * SEQ + (size_t)lq * a.dil + a.r;
#pragma unroll
    for (int ks = 0; ks < 2; ++ks) qv[ks] = *(const GAS v4u*)(INP + qrow * NIN + OFF_BQ + a.head * 64 + ks * 32 + (F.lane >> 4) * 8);
    bs = (F.tid < 129) ? BT[(a.g * 4 + a.s) * 132 + F.tid] : 0.f;
}
__device__ __forceinline__ void attn_phase(Frame& F) {
    float* AO = (float*)(F.ws + WS_ATTO); float* AL = (float*)(F.ws + WS_ATTL);
    LAS unsigned char* Ks = F.lds + ATT_K_OFF; LAS unsigned char* Vs = F.lds + ATT_V_OFF; LAS float* Bs = (LAS float*)(F.lds + ATT_B_OFF);
    const int w = F.wave, qcol = F.lane & 15, g4 = F.lane >> 4;
    int it = F.bid;
    if (it >= 768) return;
    AttItem cur = att_decode(it);
    v4u kvr[4], vvr[4], qvr[2]; float bsr;
    att_load(F, cur, kvr, vvr, qvr, bsr);
    for (; it < 768; it += F.G) {
        const int g = cur.g, b = cur.b, s = cur.s, r = cur.r, qb = cur.qb, dil = cur.dil;
        __syncthreads();
#pragma unroll
        for (int i = 0; i < 4; ++i) { const int row = (F.tid >> 3) + 64 * i, ch = F.tid & 7;
            *(LAS v4u*)(Ks + row * ATT_KS + ch * 16) = kvr[i]; *(LAS v4u*)(Vs + row * ATT_VS + ch * 16) = vvr[i]; }
        if (F.tid < 128) *(LAS v4u*)(Vs + (256 + (F.tid >> 3)) * ATT_VS + (F.tid & 7) * 16) = (v4u){0u, 0u, 0u, 0u};
        if (F.tid < 129) Bs[F.tid] = bsr;
        const int lq = 128 * qb + 16 * w + qcol; const size_t qrow = (size_t)b * SEQ + (size_t)lq * dil + r;
        s16x8 qf[2];
#pragma unroll
        for (int ks = 0; ks < 2; ++ks) qf[ks] = __builtin_bit_cast(s16x8, qvr[ks]);
        __syncthreads();
        if (it + F.G < 768) { cur = att_decode(it + F.G); att_load(F, cur, kvr, vvr, qvr, bsr); }
        float sc[9][4];
#pragma unroll
        for (int i = 0; i < 9; ++i) {
            pg8::f32x4 a4 = (pg8::f32x4){0.f, 0.f, 0.f, 0.f};
#pragma unroll
            for (int ks = 0; ks < 2; ++ks) { const s16x8 kf = *(const LAS s16x8*)(Ks + (16 * (w + i) + qcol) * ATT_KS + ks * 64 + g4 * 16);
                a4 = __builtin_amdgcn_mfma_f32_16x16x32_bf16(kf, qf[ks], a4, 0, 0, 0); }
#pragma unroll
            for (int rg = 0; rg < 4; ++rg) { const int keyrow = 4 * g4 + rg; const int j = 128 - 16 * i + qcol - keyrow;
                const int lp = 128 * (qb - 1) + 16 * (w + i) + keyrow;
                const bool valid = (j >= 0) && (j <= 128) && (lp >= 0);
                const float bias = Bs[valid ? j : 0];
                sc[i][rg] = valid ? (a4[rg] * 0.125f + bias) : -1e30f; }
        }
        float mx = -1e30f;
#pragma unroll
        for (int i = 0; i < 9; ++i)
#pragma unroll
            for (int rg = 0; rg < 4; ++rg) mx = fmaxf(mx, sc[i][rg]);
        mx = fmaxf(mx, __shfl_xor(mx, 16)); mx = fmaxf(mx, __shfl_xor(mx, 32));
        float z = 0.f; unsigned pp[10][2];
#pragma unroll
        for (int i = 0; i < 9; ++i) { float p[4];
#pragma unroll
            for (int rg = 0; rg < 4; ++rg) { p[rg] = __expf(sc[i][rg] - mx); z += p[rg]; }
            pp[i][0] = pk2(p[0], p[1]); pp[i][1] = pk2(p[2], p[3]); }
        pp[9][0] = 0u; pp[9][1] = 0u;
        z += __shfl_xor(z, 16); z += __shfl_xor(z, 32);
        pg8::f32x4 oa[4];
#pragma unroll
        for (int dt = 0; dt < 4; ++dt) oa[dt] = (pg8::f32x4){0.f, 0.f, 0.f, 0.f};
#pragma unroll
        for (int c = 0; c < 5; ++c) {
            v4u pw; pw.x = pp[2 * c][0]; pw.y = pp[2 * c][1]; pw.z = pp[2 * c + 1][0]; pw.w = pp[2 * c + 1][1];
            const s16x8 pf = __builtin_bit_cast(s16x8, pw);
#pragma unroll
            for (int dt = 0; dt < 4; ++dt) {
                LAS unsigned char* va = Vs + (16 * (w + 2 * c) + 4 * g4 + (qcol >> 2)) * ATT_VS + (16 * dt + 4 * (qcol & 3)) * 2;
                const s16x4 v0 = lds_tr16(va), v1 = lds_tr16(va + 16 * ATT_VS);
                const s16x8 vf = (s16x8){v0[0], v0[1], v0[2], v0[3], v1[0], v1[1], v1[2], v1[3]};
                oa[dt] = __builtin_amdgcn_mfma_f32_16x16x32_bf16(vf, pf, oa[dt], 0, 0, 0);
            }
        }
        const float iz = 1.0f / z;
        float* op = AO + ((size_t)g * M + qrow) * 256 + s * 64 + 4 * g4;
#pragma unroll
        for (int dt = 0; dt < 4; ++dt) *(GAS f32x4*)(op + 16 * dt) = oa[dt] * iz;
        if (g4 == 0) AL[((size_t)g * M + qrow) * 4 + s] = mx + __logf(z);
    }
}
__device__ __forceinline__ void attn_combine_phase(Frame& F, bf16* YC) {
    const float* AO = (const float*)(F.ws + WS_ATTO); const float* AL = (const float*)(F.ws + WS_ATTL);
    for (int id = F.bid * NTHREADS + F.tid; id < M * 32; id += F.G * NTHREADS) {
        const int c8 = id & 31, row = id >> 5, s = c8 >> 3;
        const float l0 = AL[((size_t)0 * M + row) * 4 + s], l1 = AL[((size_t)1 * M + row) * 4 + s], l2 = AL[((size_t)2 * M + row) * 4 + s];
        const float mx = fmaxf(l0, fmaxf(l1, l2)); const float e0 = __expf(l0 - mx), e1 = __expf(l1 - mx), e2 = __expf(l2 - mx), inv = 1.0f / (e0 + e1 + e2);
        f32x4 a = (f32x4){0.f, 0.f, 0.f, 0.f}, bq = a;
        { const GAS f32x4* p = (const GAS f32x4*)(AO + ((size_t)0 * M + row) * 256 + c8 * 8); a = a + p[0] * (e0 * inv); bq = bq + p[1] * (e0 * inv); }
        { const GAS f32x4* p = (const GAS f32x4*)(AO + ((size_t)1 * M + row) * 256 + c8 * 8); a = a + p[0] * (e1 * inv); bq = bq + p[1] * (e1 * inv); }
        { const GAS f32x4* p = (const GAS f32x4*)(AO + ((size_t)2 * M + row) * 256 + c8 * 8); a = a + p[0] * (e2 * inv); bq = bq + p[1] * (e2 * inv); }
        v4u o; o.x = pk2(a.x, a.y); o.y = pk2(a.z, a.w); o.z = pk2(bq.x, bq.y); o.w = pk2(bq.z, bq.w);
        *(GAS v4u*)(YC + (size_t)row * DM + YC_B + c8 * 8) = o;
    }
}


constexpr int HG_QD = 0, HG_KINV = 17408, HG_KDT = 34816, HG_VS = 52224, HG_DEC = 70656, HG_O = 72704;
__device__ __forceinline__ s16x4 pack4(float a, float b, float c, float d) { v2u w; w.x = pk2(a, b); w.y = pk2(c, d); return __builtin_bit_cast(s16x4, w); }
template <bool OUT> __device__ __forceinline__ void hgrn_group_phase(Frame& F, int l, bf16* YC) {
    const Args& A = *F.a;
    const bf16* INP = (const bf16*)(F.ws + WS_INP);
    float* HS = (float*)(F.ws + WS_HSTATE); float* HD = (float*)(F.ws + WS_HDEC);
    const float* LB = (const float*)(F.ws + WS_LB) + l * 1024; const float* NW = A.in[IN_HNW] + l * 128;
    LAS unsigned char* QD = F.lds + HG_QD; LAS unsigned char* KINV = F.lds + HG_KINV; LAS unsigned char* KDT = F.lds + HG_KDT; LAS unsigned char* VS = F.lds + HG_VS;
    LAS float* DEC = (LAS float*)(F.lds + HG_DEC); LAS float* OB = (LAS float*)(F.lds + HG_O);
    const int w = F.wave, li = F.lane & 15, g4 = F.lane >> 4;
    const int pk = F.tid & 127, pi = F.tid >> 7;
    for (int it = F.bid; it < 256; it += F.G) {
        const int bh = it >> 3, grp = it & 7, b = bh >> 3, h = bh & 7;
        pg8::f32x4 R[8];
#pragma unroll
        for (int kb = 0; kb < 8; ++kb) R[kb] = (pg8::f32x4){0.f, 0.f, 0.f, 0.f};
        if (OUT && grp > 0) {
            const float* hs = HS + (size_t)(bh * 8) * 16384 + (size_t)(4 * g4) * 128 + 16 * w + li; const float* dj = HD + (size_t)(bh * 8) * 128 + 4 * g4;
            float nx[8][4]; f32x4 nd[8];
#pragma unroll
            for (int kb = 0; kb < 8; ++kb) { nd[kb] = *(const GAS f32x4*)(dj + 16 * kb);
#pragma unroll
                for (int rg = 0; rg < 4; ++rg) nx[kb][rg] = hs[(16 * kb + rg) * 128]; }
#pragma unroll 1
            for (int j = 0; j < grp; ++j) {
                float cx[8][4]; f32x4 cd[8];
#pragma unroll
                for (int kb = 0; kb < 8; ++kb) { cd[kb] = nd[kb];
#pragma unroll
                    for (int rg = 0; rg < 4; ++rg) cx[kb][rg] = nx[kb][rg]; }
                if (j + 1 < grp) { hs += 16384; dj += 128;
#pragma unroll
                    for (int kb = 0; kb < 8; ++kb) { nd[kb] = *(const GAS f32x4*)(dj + 16 * kb);
#pragma unroll
                        for (int rg = 0; rg < 4; ++rg) nx[kb][rg] = hs[(16 * kb + rg) * 128]; } }
#pragma unroll
                for (int kb = 0; kb < 8; ++kb)
#pragma unroll
                    for (int rg = 0; rg < 4; ++rg) R[kb][rg] = cd[kb][rg] * R[kb][rg] + cx[kb][rg];
            }
        }
        float decp = 1.0f;
        const float lbk = LB[h * 128 + pk];
#pragma unroll 1
        for (int c4 = 0; c4 < 4; ++c4) {
            const size_t row0 = (size_t)b * SEQ + 256 * grp + 64 * c4;
            __syncthreads();
#pragma unroll
            for (int i = 0; i < 2; ++i) { const int e = F.tid + 512 * i, r = e >> 4, ch = e & 15;
                *(LAS v4u*)(VS + r * 288 + ch * 16) = *(const GAS v4u*)(INP + (row0 + r) * NIN + OFF_AI + h * 128 + ch * 8); }
            {
                float c[16], kk[16], qs[16];
                bf16 zr[16], qr[16];
#pragma unroll
                for (int t = 0; t < 16; ++t) { const size_t ro = (row0 + 16 * pi + t) * NIN + h * 128 + pk; zr[t] = INP[ro + OFF_AF]; if (OUT) qr[t] = INP[ro + OFF_AQ]; }
                float run = 1.f;
#pragma unroll
                for (int t = 0; t < 16; ++t) { const float kt = (1.f - lbk) * bf2f(zr[t]); const float f = 1.f - kt; run *= f; c[t] = run; kk[t] = kt;
                    qs[t] = f;
                }
                DEC[pi * 128 + pk] = c[15];
                {
                    float sx[16]; float suf = 1.f;
#pragma unroll
                    for (int t = 15; t >= 0; --t) { sx[t] = suf; suf *= qs[t]; }
#pragma unroll
                    for (int t = 0; t < 16; t += 4) {
                        const s16x4 kd = pack4(kk[t] * sx[t], kk[t + 1] * sx[t + 1], kk[t + 2] * sx[t + 2], kk[t + 3] * sx[t + 3]);
                        *(LAS s16x4*)(KDT + pk * 136 + pi * 32 + t * 2) = kd; }
                }
                if (OUT) {
#pragma unroll
                    for (int t = 0; t < 16; t += 2) {
                        const float q0 = bf2f(qr[t]), q1 = bf2f(qr[t + 1]);
                        const unsigned qd2 = pk2(q0 * c[t], q1 * c[t + 1]);
                        const unsigned ki2 = pk2(kk[t] * __builtin_amdgcn_rcpf(fmaxf(c[t], 1e-35f)), kk[t + 1] * __builtin_amdgcn_rcpf(fmaxf(c[t + 1], 1e-35f)));
                        *(LAS bf16*)(QD + (16 * pi + t) * 272 + pk * 2) = (bf16)(qd2 & 0xffffu); *(LAS bf16*)(QD + (16 * pi + t + 1) * 272 + pk * 2) = (bf16)(qd2 >> 16);
                        *(LAS bf16*)(KINV + (16 * pi + t) * 272 + pk * 2) = (bf16)(ki2 & 0xffffu); *(LAS bf16*)(KINV + (16 * pi + t + 1) * 272 + pk * 2) = (bf16)(ki2 >> 16); }
                }
            }
            unsigned ogw[8];
            if (OUT) {
#pragma unroll
                for (int q8 = 0; q8 < 8; ++q8) ogw[q8] = *(const GAS unsigned*)(INP + (row0 + 8 * w + q8) * NIN + OFF_AG + h * 128 + 2 * F.lane);
            }
            __syncthreads();
            if (!OUT && F.tid < 128) decp *= (DEC[F.tid] * DEC[128 + F.tid]) * (DEC[256 + F.tid] * DEC[384 + F.tid]);
#pragma unroll 1
            for (int i = 0; i < 4; ++i) {
                const s16x4 vf = lds_tr16(VS + (16 * i + 4 * g4 + (li >> 2)) * 288 + (16 * w + 4 * (li & 3)) * 2);
                if (OUT) {
                    pg8::f32x4 ad = (pg8::f32x4){0.f, 0.f, 0.f, 0.f}; s16x4 qf[8];
#pragma unroll
                    for (int kb = 0; kb < 8; ++kb) { const s16x4 kf = *(const LAS s16x4*)(KINV + (16 * i + li) * 272 + (16 * kb + 4 * g4) * 2);
                        qf[kb] = *(const LAS s16x4*)(QD + (16 * i + li) * 272 + (16 * kb + 4 * g4) * 2);
                        ad = __builtin_amdgcn_mfma_f32_16x16x16bf16_1k(kf, qf[kb], ad, 0, 0, 0); }
#pragma unroll
                    for (int rg = 0; rg < 4; ++rg) if (4 * g4 + rg > li) ad[rg] = 0.f;
                    const s16x4 adf = pack4(ad[0], ad[1], ad[2], ad[3]);
                    pg8::f32x4 oT = __builtin_amdgcn_mfma_f32_16x16x16bf16_1k(vf, adf, (pg8::f32x4){0.f, 0.f, 0.f, 0.f}, 0, 0, 0);
#pragma unroll
                    for (int kb = 0; kb < 8; ++kb) { const s16x4 rf = pack4(R[kb][0], R[kb][1], R[kb][2], R[kb][3]);
                        oT = __builtin_amdgcn_mfma_f32_16x16x16bf16_1k(rf, qf[kb], oT, 0, 0, 0); }
                    *(LAS pg8::f32x4*)(OB + (16 * i + li) * 132 + 16 * w + 4 * g4) = oT;
                }
#pragma unroll
                for (int kb = 0; kb < 8; ++kb) { const pg8::f32x4 dv = *(const LAS pg8::f32x4*)(DEC + i * 128 + 16 * kb + 4 * g4);
                    const s16x4 kdf = *(const LAS s16x4*)(KDT + (16 * kb + li) * 136 + i * 32 + g4 * 8);
                    R[kb] = __builtin_amdgcn_mfma_f32_16x16x16bf16_1k(kdf, vf, R[kb] * dv, 0, 0, 0); }
            }
            if (OUT) {
                const float nw0 = NW[2 * F.lane], nw1 = NW[2 * F.lane + 1];
                __syncthreads();
#pragma unroll
                for (int q8 = 0; q8 < 8; ++q8) { const int t = 8 * w + q8; const size_t row = row0 + t;
                    const float o1 = OB[t * 132 + 2 * F.lane], o2 = OB[t * 132 + 2 * F.lane + 1];
                    const float r = __builtin_amdgcn_rsqf(wave_sum(o1 * o1 + o2 * o2) * (1.0f / 128.f) + EPS);
                    const float g1 = bflo(ogw[q8]), g2 = bfhi(ogw[q8]);
                    *(GAS unsigned*)(YC + row * DM + YC_A + h * 128 + 2 * F.lane) = pk2(o1 * r * nw0 * g1, o2 * r * nw1 * g2); }
            }
        }
        if (!OUT) {
            float* hs = HS + (size_t)it * 16384 + (size_t)(4 * g4) * 128 + 16 * w + li;
#pragma unroll
            for (int kb = 0; kb < 8; ++kb)
#pragma unroll
                for (int rg = 0; rg < 4; ++rg) hs[(16 * kb + rg) * 128] = R[kb][rg];
            if (F.tid < 128) HD[(size_t)it * 128 + F.tid] = decp;
        }
    }
}

constexpr int N_PHASES = 2 + 9 * DEPTH;
#define IN(p) (lo <= (p) && (p) < hi)
#define SEAM(p) do { if ((p) + 1 < hi) xcd_barrier(bar); } while (0)
template <int L> __device__ __forceinline__ void layer_phases(Frame& F, const Args& args, const int lo, const int hi, const XcdBarrier& bar) {
    constexpr int P0 = 2 + 9 * L;
    if (IN(P0 + 0)) {
        unsigned char* wl = F.ws + WS_W + (size_t)L * W_LAYER;
        const int NG = (L == 0 && F.G > G1_GEMM_CUS) ? G1_GEMM_CUS : F.G;
        if (F.bid < NG) {
            pg8::Gemm g{(const bf16*)(F.ws + WS_H), (const bf16*)(wl + WO_CAT1), DM, DM}; pg8::StaticOrder S; S.init(M, N1, DM, NG, F.bid);
            pg8::EpiInGate E{(bf16*)(F.ws + WS_INP), (bf16*)(F.ws + WS_GATES), args.in[IN_BGATE] + L * NGATE};
            pg8::gemm_phase<pg8::EpiInGate, pg8::StaticOrder>(F.lds + RING_OFF, g, S, E);
        } else if (L == 0) { if (GEMV_FIRST < GEMV_ALL) gemv_items(F, GEMV_FIRST, GEMV_ALL, F.bid - NG, F.G - NG); transposes(F, (F.bid - NG) * NWAVES + F.wave, (F.G - NG) * NWAVES, TR_FIRST, 2 * TR_PER_LAYER); }
        SEAM(P0 + 0);
    }
    if (IN(P0 + 1)) {
        hgrn_group_phase<false>(F, L, nullptr); __syncthreads(); attn_phase(F); __syncthreads(); conv_phase(F, L, (bf16*)(F.ws + WS_YCAT));
        SEAM(P0 + 1);
    }
    if (IN(P0 + 2)) {
        hgrn_group_phase<true>(F, L, (bf16*)(F.ws + WS_YCAT)); __syncthreads(); attn_combine_phase(F, (bf16*)(F.ws + WS_YCAT));
        SEAM(P0 + 2);
    }
    if (IN(P0 + 3)) {
        unsigned char* wl = F.ws + WS_W + (size_t)L * W_LAYER;
        pg8::Gemm g{(const bf16*)(F.ws + WS_YCAT), (const bf16*)(wl + WO_CAT2), DM, DM}; pg8::SegOrder3 S; S.init(M, DM, F.G, F.bid);
        pg8::EpiMerge E{(bf16*)(F.ws + WS_MERGED), (const bf16*)(F.ws + WS_GATES)};
        pg8::gemm_phase<pg8::EpiMerge, pg8::SegOrder3>(F.lds + RING_OFF, g, S, E);
        SEAM(P0 + 3);
    }
    if (IN(P0 + 4)) {
        unsigned char* wl = F.ws + WS_W + (size_t)L * W_LAYER;
        pg8::Gemm g{(const bf16*)(F.ws + WS_MERGED), (const bf16*)(wl + WO_O), DM, DM}; pg8::StaticOrder S; S.init(M, DM, DM, F.G, F.bid);
        pg8::EpiBf16 E{(bf16*)(F.ws + WS_Y), DM};
        pg8::gemm_phase<pg8::EpiBf16, pg8::StaticOrder>(F.lds + RING_OFF, g, S, E);
        SEAM(P0 + 4);
    }
    if (IN(P0 + 5)) {
        const float* modl = (const float*)(F.ws + WS_MOD) + (size_t)L * 4 * 12288;
        norm_phase(F, L == 0 ? args.in[IN_X] : args.out, args.out, (const bf16*)(F.ws + WS_Y), modl + 2 * 2048, args.in[IN_NPOST] + L * DM, args.in[IN_MPRE] + L * DM, modl + 4 * 2048, modl + 3 * 2048, (bf16*)(F.ws + WS_H));
        SEAM(P0 + 5);
    }
    if (IN(P0 + 6)) {
        unsigned char* wl = F.ws + WS_W + (size_t)L * W_LAYER;
        pg8::Gemm g{(const bf16*)(F.ws + WS_H), (const bf16*)(wl + WO_UP), DM, DM}; pg8::StaticOrder S; S.init(M, DFF, DM, F.G, F.bid);
        pg8::EpiRelu2 E{(bf16*)(F.ws + WS_U), DFF};
        pg8::gemm_phase<pg8::EpiRelu2, pg8::StaticOrder>(F.lds + RING_OFF, g, S, E);
        SEAM(P0 + 6);
    }
    if (IN(P0 + 7)) {
        unsigned char* wl = F.ws + WS_W + (size_t)L * W_LAYER;
        pg8::Gemm g{(const bf16*)(F.ws + WS_U), (const bf16*)(wl + WO_DOWN), DFF, DFF}; pg8::StaticOrder S; S.init(M, DM, DFF, F.G, F.bid);
        pg8::EpiBf16 E{(bf16*)(F.ws + WS_Y), DM};
        pg8::gemm_phase<pg8::EpiBf16, pg8::StaticOrder>(F.lds + RING_OFF, g, S, E);
        SEAM(P0 + 7);
    }
    if (IN(P0 + 8)) {
        const float* modl = (const float*)(F.ws + WS_MOD) + (size_t)L * 4 * 12288;
        const float* modn = (const float*)(F.ws + WS_MOD) + (size_t)(L + 1) * 4 * 12288;
        constexpr bool lastl = (L == DEPTH - 1);
        norm_phase(F, args.out, args.out, (const bf16*)(F.ws + WS_Y), modl + 5 * 2048, args.in[IN_MPOST] + L * DM, lastl ? nullptr : args.in[IN_NPRE] + (lastl ? 0 : (L + 1)) * DM, modn + 1 * 2048, modn + 0 * 2048, (bf16*)(F.ws + WS_H));
        SEAM(P0 + 8);
    }
}
__global__ void __launch_bounds__(NTHREADS, 2) mk_fwd(Args args) {
    extern __shared__ __attribute__((aligned(16))) unsigned char lds[];
    Frame F;
    F.lds = (LAS unsigned char*)lds; F.tid = threadIdx.x; F.lane = F.tid & 63; F.wave = __builtin_amdgcn_readfirstlane(F.tid >> 6);
    F.G = gridDim.x; F.bid = blockIdx.x; F.a = &args; F.ws = args.ws;
    volatile LAS unsigned* MISC = (volatile LAS unsigned*)(F.lds + MISC_OFF);
    if (F.tid < 32) MISC[F.tid] = 0u;
    __syncthreads();
    const int lo = args.ph_lo, hi = args.ph_hi;
    XcdBarrier bar; bar.bar = (unsigned*)(F.ws + WS_CTL) + 4096; bar.x = 0; bar.st = nullptr;
    if (hi - lo > 1) bar = xcd_barrier_post((unsigned*)(F.ws + WS_CTL) + 4096, MISC + 8);
    if (IN(0)) { prep_phase(F); SEAM(0); }
    if (IN(1)) { const float* MOD = (const float*)(F.ws + WS_MOD);
        norm_phase(F, args.in[IN_X], nullptr, nullptr, nullptr, nullptr, args.in[IN_NPRE], MOD + 1 * 2048, MOD + 0 * 2048, (bf16*)(F.ws + WS_H)); SEAM(1); }
    layer_phases<0>(F, args, lo, hi, bar);
    layer_phases<1>(F, args, lo, hi, bar);
}

extern "C" void kernel_launch(void* const* d_in, const int* in_sizes, int n_in, void* d_out, int out_size, void* d_ws, size_t ws_size, hipStream_t stream) {
    static int grid = 0;
    if (grid == 0) {
        if (n_in != 24 || out_size != M * DM || ws_size < WS_END) { fprintf(stderr, "kernel_launch: unexpected problem (n_in %d, out %d, ws %zu)\n", n_in, out_size, ws_size); grid = -1; return; }
        int dev = 0, cus = 0, per_cu = 0;
        if (hipGetDevice(&dev) != hipSuccess || hipDeviceGetAttribute(&cus, hipDeviceAttributeMultiprocessorCount, dev) != hipSuccess) { grid = -1; return; }
        if (hipFuncSetAttribute((const void*)mk_fwd, hipFuncAttributeMaxDynamicSharedMemorySize, LDS_BYTES) != hipSuccess) { fprintf(stderr, "kernel_launch: hipFuncSetAttribute failed\n"); grid = -1; return; }
        if (hipOccupancyMaxActiveBlocksPerMultiprocessor(&per_cu, (const void*)mk_fwd, NTHREADS, LDS_BYTES) != hipSuccess || per_cu < 1) { fprintf(stderr, "kernel_launch: occupancy query says %d blocks/CU\n", per_cu); grid = -1; (void)hipGetLastError(); return; }
        grid = cus;
    }
    if (grid < 0) return;
    (void)hipMemsetAsync((char*)d_ws + WS_CTL, 0, CTL_ZERO_BYTES, stream);
    Args a{};
    for (int i = 0; i < 24; ++i) a.in[i] = (const float*)d_in[i];
    a.out = (float*)d_out; a.ws = (unsigned char*)d_ws;
#if MK_ONE_LAUNCH
    a.ph_lo = 0; a.ph_hi = N_PHASES;
    void* kargs[] = {&a};
    hipError_t e = hipLaunchCooperativeKernel((const void*)mk_fwd, dim3(grid), dim3(NTHREADS), kargs, LDS_BYTES, stream);
    if (e != hipSuccess) fprintf(stderr, "kernel_launch: cooperative launch failed: %s\n", hipGetErrorString(e));
    if (PROBE_PHASE >= 0) { a.ph_lo = PROBE_PHASE; a.ph_hi = PROBE_PHASE + 1; hipLaunchKernelGGL(mk_fwd, dim3(grid), dim3(NTHREADS), LDS_BYTES, stream, a); }
#else
    for (int p = 0; p < N_PHASES; ++p) { a.ph_lo = p; a.ph_hi = p + 1; hipLaunchKernelGGL(mk_fwd, dim3(grid), dim3(NTHREADS), LDS_BYTES, stream, a); }
#endif
}
```

```cpp
#include <hip/hip_runtime.h>
#include <cstdio>
#include <cstdint>

#ifndef PROBE_PHASE
#define PROBE_PHASE -1
#endif
#ifndef MK_ONE_LAUNCH
#define MK_ONE_LAUNCH 1
#endif

namespace pg8 {
#define PG8_LAS __attribute__((address_space(3)))
typedef unsigned short bf16_t;
typedef short bf16x8 __attribute__((ext_vector_type(8)));
typedef float f32x4 __attribute__((ext_vector_type(4)));
typedef unsigned u32x4 __attribute__((ext_vector_type(4)));
constexpr int BM = 256, BK = 64, HALF = 128, HTB = HALF * BK * 2, STAGE_BYTES = 8 * HTB, NXCD = 8, WGM = 4;

__host__ __device__ __forceinline__ int lds_byte(int r, int c) { const int st = (r >> 4) * 2 + (c >> 5), rr = r & 15, cc = c & 31, ob = rr * 64 + cc * 2; return st * 1024 + (ob ^ (((ob >> 9) & 1) << 5)); }
__host__ __device__ __forceinline__ void stage_rc(int b, int& R, int& C) { const int st = b / 1024, sb = b % 1024, swz = sb ^ (((sb >> 9) & 1) << 5); R = (st >> 1) * 16 + swz / 64; C = (st & 1) * 32 + (swz % 64) / 2; }
__host__ __device__ __forceinline__ int perm32(int rho) { const int n = rho >> 4, i = rho & 15; return 8 * (i >> 2) + 4 * n + (i & 3); }

struct Unit { int pm, pn, koff, nt, seg; };
struct Gemm { const bf16_t* A; const bf16_t* Bt; int lda, ldb; };

__device__ __forceinline__ void tile_of(int L, int nM, int nN, int& pm, int& pn) {
    const int nwg = nM * nN; int wgid = L;
    { const int q = nwg / NXCD, r = nwg % NXCD, xcd = wgid % NXCD, off = wgid / NXCD; wgid = (xcd < r ? xcd * (q + 1) : r * (q + 1) + (xcd - r) * q) + off; }
    const int nig = WGM * nN, gid = wgid / nig, fm = gid * WGM, gsz = (nM - fm) < WGM ? (nM - fm) : WGM;
    pm = fm + ((wgid % nig) % gsz); pn = (wgid % nig) / gsz;
}
struct StaticOrder {
    int nM, nN, nwg, G, c, nt;
    __device__ void init(int M, int N, int K, int G_, int c_) { nM = M / BM; nN = N / BM; nwg = nM * nN; G = G_; c = c_; nt = K / BK; }
    __device__ bool next(int i, Unit& u) const {
        const long L = (long)i * G + c; if (L >= nwg) return false;
        tile_of((int)L, nM, nN, u.pm, u.pn); u.koff = 0; u.nt = nt; u.seg = 0; return true;
    }
};
struct SegOrder3 {
    int nM, nN, nwg, G, c;
    __device__ void init(int M, int N, int G_, int c_) { nM = M / BM; nN = N / BM; nwg = nM * nN; G = G_; c = c_; }
    __device__ bool next(int i, Unit& u) const {
        const int ti = i / 3, seg = i - ti * 3; const long L = (long)ti * G + c; if (L >= nwg) return false;
        tile_of((int)L, nM, nN, u.pm, u.pn); u.seg = seg;
        u.koff = seg == 0 ? 0 : (seg == 1 ? 1024 : 1280); u.nt = seg == 0 ? 16 : (seg == 1 ? 4 : 12); return true;
    }
};

typedef __bf16 bf16x2_t __attribute__((ext_vector_type(2)));
__device__ __forceinline__ unsigned cvt_pk_bf16(float lo, float hi) { bf16x2_t v; v[0] = (__bf16)lo; v[1] = (__bf16)hi; return __builtin_bit_cast(unsigned, v); }
__device__ __forceinline__ float bf_lo(unsigned w) { return __uint_as_float(w << 16); }
__device__ __forceinline__ float bf_hi(unsigned w) { return __uint_as_float(w & 0xffff0000u); }
__device__ __forceinline__ float sigmoidf_fast(float x) { return __builtin_amdgcn_rcpf(1.0f + __expf(-x)); }

struct EpiF32 {
    static constexpr bool PERM = false, KEEP_ACC = false;
    float* C; int ldc;
    __device__ __forceinline__ void operator()(const f32x4 (&acc)[2][2][4][2], const Unit& u, int wr, int wc, int fr, int fq) const {
        const int row0 = u.pm * BM + wr * 64 + fr, col0 = u.pn * BM + wc * 32 + 4 * fq;
#pragma unroll
        for (int ai = 0; ai < 2; ++ai)
#pragma unroll
            for (int m = 0; m < 4; ++m) { float* rowp = C + (size_t)(row0 + ai * HALF + m * 16) * ldc + col0;
#pragma unroll
                for (int bj = 0; bj < 2; ++bj)
#pragma unroll
                    for (int n = 0; n < 2; ++n) *(f32x4*)(rowp + bj * HALF + n * 16) = acc[ai][bj][m][n]; }
    }
};
struct EpiBf16 {
    static constexpr bool PERM = true, KEEP_ACC = false;
    bf16_t* O; int ldc;
    __device__ __forceinline__ void operator()(const f32x4 (&acc)[2][2][4][2], const Unit& u, int wr, int wc, int fr, int fq) const {
        const int row0 = u.pm * BM + wr * 64 + fr, col0 = u.pn * BM + wc * 32 + 8 * fq;
#pragma unroll
        for (int ai = 0; ai < 2; ++ai)
#pragma unroll
            for (int m = 0; m < 4; ++m) { bf16_t* rowp = O + (size_t)(row0 + ai * HALF + m * 16) * ldc + col0;
#pragma unroll
                for (int bj = 0; bj < 2; ++bj) { const f32x4 v0 = acc[ai][bj][m][0], v1 = acc[ai][bj][m][1];
                    u32x4 w; w.x = cvt_pk_bf16(v0[0], v0[1]); w.y = cvt_pk_bf16(v0[2], v0[3]); w.z = cvt_pk_bf16(v1[0], v1[1]); w.w = cvt_pk_bf16(v1[2], v1[3]);
                    *(u32x4*)(rowp + bj * HALF) = w; } }
    }
};
struct EpiInGate {
    static constexpr bool PERM = true, KEEP_ACC = false;
    bf16_t* INP; bf16_t* GATES; const float* bgate;
    __device__ __forceinline__ void operator()(const f32x4 (&acc)[2][2][4][2], const Unit& u, int wr, int wc, int fr, int fq) const {
        const int row0 = u.pm * BM + wr * 64 + fr; const bool gate = u.pn >= 31;
        const int colt = (gate ? (u.pn - 31) : u.pn) * BM, ldc = gate ? 6144 : 7936; bf16_t* base = gate ? GATES : INP;
        const int col0 = colt + wc * 32 + 8 * fq;
        f32x4 bv[2][2];
#pragma unroll
        for (int bj = 0; bj < 2; ++bj)
#pragma unroll
            for (int n = 0; n < 2; ++n) bv[bj][n] = gate ? *(const f32x4*)(bgate + col0 + bj * HALF + 4 * n) : (f32x4){0.f, 0.f, 0.f, 0.f};
        if (u.pn >= 25 && u.pn < 31) {
            bf16_t* ub = INP + (size_t)row0 * 7936 + 6400 + (u.pn - 25) * 128 + wc * 32 + 8 * fq;
#pragma unroll
            for (int ai = 0; ai < 2; ++ai)
#pragma unroll
                for (int m = 0; m < 4; ++m) { f32x4 v0 = acc[ai][0][m][0], v1 = acc[ai][0][m][1]; const f32x4 g0 = acc[ai][1][m][0], g1 = acc[ai][1][m][1];
#pragma unroll
                    for (int j = 0; j < 4; ++j) { v0[j] *= sigmoidf_fast(g0[j]); v1[j] *= sigmoidf_fast(g1[j]); }
                    u32x4 w; w.x = cvt_pk_bf16(v0[0], v0[1]); w.y = cvt_pk_bf16(v0[2], v0[3]); w.z = cvt_pk_bf16(v1[0], v1[1]); w.w = cvt_pk_bf16(v1[2], v1[3]);
                    *(u32x4*)(ub + (size_t)(ai * HALF + m * 16) * 7936) = w; }
            return;
        }
        const int hact = (u.pn < 4 || (u.pn >= 12 && u.pn < 16)) ? 1 : ((u.pn >= 4 && u.pn < 8) ? 2 : 0);
#pragma unroll
        for (int ai = 0; ai < 2; ++ai)
#pragma unroll
            for (int m = 0; m < 4; ++m) { bf16_t* rowp = base + (size_t)(row0 + ai * HALF + m * 16) * ldc + col0;
#pragma unroll
                for (int bj = 0; bj < 2; ++bj) { f32x4 v0 = acc[ai][bj][m][0] + bv[bj][0], v1 = acc[ai][bj][m][1] + bv[bj][1];
                    if (hact == 1) {
#pragma unroll
                        for (int j = 0; j < 4; ++j) { v0[j] *= sigmoidf_fast(v0[j]); v1[j] *= sigmoidf_fast(v1[j]); } }
                    if (hact == 2) {
#pragma unroll
                        for (int j = 0; j < 4; ++j) { v0[j] = sigmoidf_fast(-v0[j]); v1[j] = sigmoidf_fast(-v1[j]); } }
                    if (gate) {
#pragma unroll
                        for (int j = 0; j < 4; ++j) { v0[j] = fmaxf(sigmoidf_fast(v0[j]), 1e-20f); v1[j] = fmaxf(sigmoidf_fast(v1[j]), 1e-20f); } }
                    u32x4 w; w.x = cvt_pk_bf16(v0[0], v0[1]); w.y = cvt_pk_bf16(v0[2], v0[3]); w.z = cvt_pk_bf16(v1[0], v1[1]); w.w = cvt_pk_bf16(v1[2], v1[3]);
                    *(u32x4*)(rowp + bj * HALF) = w; } }
    }
};
struct EpiRelu2 {
    static constexpr bool PERM = true, KEEP_ACC = false;
    bf16_t* O; int ldc;
    __device__ __forceinline__ void operator()(const f32x4 (&acc)[2][2][4][2], const Unit& u, int wr, int wc, int fr, int fq) const {
        const int row0 = u.pm * BM + wr * 64 + fr, col0 = u.pn * BM + wc * 32 + 8 * fq;
#pragma unroll
        for (int ai = 0; ai < 2; ++ai)
#pragma unroll
            for (int m = 0; m < 4; ++m) { bf16_t* rowp = O + (size_t)(row0 + ai * HALF + m * 16) * ldc + col0;
#pragma unroll
                for (int bj = 0; bj < 2; ++bj) { f32x4 v0 = acc[ai][bj][m][0], v1 = acc[ai][bj][m][1];
#pragma unroll
                    for (int j = 0; j < 4; ++j) { const float a = fmaxf(v0[j], 0.f), b = fmaxf(v1[j], 0.f); v0[j] = a * a; v1[j] = b * b; }
                    u32x4 w; w.x = cvt_pk_bf16(v0[0], v0[1]); w.y = cvt_pk_bf16(v0[2], v0[3]); w.z = cvt_pk_bf16(v1[0], v1[1]); w.w = cvt_pk_bf16(v1[2], v1[3]);
                    *(u32x4*)(rowp + bj * HALF) = w; } }
    }
};
struct EpiMerge {
    static constexpr bool PERM = true, KEEP_ACC = true;
    bf16_t* MERGED; const bf16_t* GATES;
    __device__ __forceinline__ void operator()(f32x4 (&acc)[2][2][4][2], const Unit& u, int wr, int wc, int fr, int fq) const {
        const int row0 = u.pm * BM + wr * 64 + fr, col0 = u.pn * BM + wc * 32 + 8 * fq; const int seg = u.seg;
#pragma unroll
        for (int ai = 0; ai < 2; ++ai)
#pragma unroll
            for (int m = 0; m < 4; ++m) { const size_t row = (size_t)(row0 + ai * HALF + m * 16);
#pragma unroll
                for (int bj = 0; bj < 2; ++bj) {
                    const bf16_t* gp = GATES + row * 6144 + col0 + bj * HALF;
                    f32x4& a0 = acc[ai][bj][m][0]; f32x4& a1 = acc[ai][bj][m][1];
                    if (seg != 2) {
                        const u32x4 gn = *(const u32x4*)(gp + seg * 2048), gd = *(const u32x4*)(gp + (seg + 1) * 2048);
                        a0[0] *= bf_lo(gn.x) * __builtin_amdgcn_rcpf(bf_lo(gd.x)); a0[1] *= bf_hi(gn.x) * __builtin_amdgcn_rcpf(bf_hi(gd.x));
                        a0[2] *= bf_lo(gn.y) * __builtin_amdgcn_rcpf(bf_lo(gd.y)); a0[3] *= bf_hi(gn.y) * __builtin_amdgcn_rcpf(bf_hi(gd.y));
                        a1[0] *= bf_lo(gn.z) * __builtin_amdgcn_rcpf(bf_lo(gd.z)); a1[1] *= bf_hi(gn.z) * __builtin_amdgcn_rcpf(bf_hi(gd.z));
                        a1[2] *= bf_lo(gn.w) * __builtin_amdgcn_rcpf(bf_lo(gd.w)); a1[3] *= bf_hi(gn.w) * __builtin_amdgcn_rcpf(bf_hi(gd.w));
                    } else {
                        const u32x4 g = *(const u32x4*)(gp + 2 * 2048);
                        u32x4 w; w.x = cvt_pk_bf16(a0[0] * bf_lo(g.x), a0[1] * bf_hi(g.x)); w.y = cvt_pk_bf16(a0[2] * bf_lo(g.y), a0[3] * bf_hi(g.y));
                        w.z = cvt_pk_bf16(a1[0] * bf_lo(g.z), a1[1] * bf_hi(g.z)); w.w = cvt_pk_bf16(a1[2] * bf_lo(g.w), a1[3] * bf_hi(g.w));
                        *(u32x4*)(MERGED + row * 2048 + col0 + bj * HALF) = w; } } }
    }
};

template <class Epi, class Sched, bool ALIGN_EPI = true>
__device__ __forceinline__ void gemm_phase(PG8_LAS unsigned char* lds, const Gemm g, const Sched& S, const Epi& E) {
    const int tid = threadIdx.x, wid = __builtin_amdgcn_readfirstlane(tid >> 6), lane = tid & 63, wr = wid >> 2, wc = wid & 3, fr = lane & 15, fq = lane >> 4;
    unsigned voffA[2], voffB[2];
#pragma unroll
    for (int i = 0; i < 2; ++i) { int R, C; stage_rc(tid * 16 + i * 8192, R, C); const int Rb = Epi::PERM ? ((R & ~31) + perm32(R & 31)) : R;
        voffA[i] = (unsigned)(R * g.lda + C) * 2u; voffB[i] = (unsigned)(Rb * g.ldb + C) * 2u; }
    const size_t kstep = (size_t)(BK * 2);
    const size_t hstepA = (size_t)HALF * g.lda * 2, hstepB = (size_t)HALF * g.ldb * 2;
    const size_t tstepA = 2 * hstepA, tstepB = 2 * hstepB;
    const unsigned ldsw = (unsigned)wid * 1024u;
    const int aoff = lds_byte(wr * 64 + fr, fq * 8), boff = lds_byte(wc * 32 + fr, fq * 8);
#define PG8_SA(b, h) (((b) * 2 + (h)) * HTB)
#define PG8_SB(b, h) ((4 + (b) * 2 + (h)) * HTB)
#define PG8_STAGE(bufoff, gbase, voff) do { _Pragma("unroll") for (int _i = 0; _i < 2; ++_i) \
        __builtin_amdgcn_global_load_lds((const unsigned*)((const char*)(gbase) + (voff)[_i]), (PG8_LAS unsigned*)(lds + (bufoff) + ldsw + _i * 8192), 16, 0, 0); } while (0)
#define PG8_LDA(dst, b, h) do { _Pragma("unroll") for (int m = 0; m < 4; ++m) _Pragma("unroll") for (int k = 0; k < 2; ++k) dst[m][k] = *(const PG8_LAS bf16x8*)(lds + PG8_SA(b, h) + aoff + m * 2048 + k * 1024); } while (0)
#define PG8_LDB(dst, b, h) do { _Pragma("unroll") for (int n = 0; n < 2; ++n) _Pragma("unroll") for (int k = 0; k < 2; ++k) dst[n][k] = *(const PG8_LAS bf16x8*)(lds + PG8_SB(b, h) + boff + n * 2048 + k * 1024); } while (0)
#define PG8_MMA(ai, bj, At, Bt) do { __builtin_amdgcn_s_setprio(1); _Pragma("unroll") for (int m = 0; m < 4; ++m) _Pragma("unroll") for (int n = 0; n < 2; ++n) _Pragma("unroll") for (int k = 0; k < 2; ++k) \
        acc[ai][bj][m][n] = __builtin_amdgcn_mfma_f32_16x16x32_bf16(Bt[n][k], At[m][k], acc[ai][bj][m][n], 0, 0, 0); __builtin_amdgcn_s_setprio(0); } while (0)
#define PG8_WAIT_V(n) asm volatile("s_waitcnt vmcnt(" #n ")" ::: "memory")
#define PG8_WAIT_L(n) asm volatile("s_waitcnt lgkmcnt(" #n ")" ::: "memory")
#define PG8_BAR __builtin_amdgcn_s_barrier()
#define PG8_SCHED __builtin_amdgcn_sched_barrier(0)
    Unit cur, nxt; int ui = 0;
    if (!S.next(0, cur)) return;
    f32x4 acc[2][2][4][2];
#pragma unroll
    for (int a = 0; a < 2; ++a)
#pragma unroll
        for (int b = 0; b < 2; ++b)
#pragma unroll
            for (int m = 0; m < 4; ++m)
#pragma unroll
                for (int n = 0; n < 2; ++n) acc[a][b][m][n] = (f32x4){0.f, 0.f, 0.f, 0.f};
    bf16x8 At[4][2], B0[2][2], B1[2][2];
    const char* cA = (const char*)g.A + (size_t)cur.pm * tstepA + (size_t)cur.koff * 2; const char* cB = (const char*)g.Bt + (size_t)cur.pn * tstepB + (size_t)cur.koff * 2;
    PG8_STAGE(PG8_SB(0, 0), cB, voffB); PG8_STAGE(PG8_SB(0, 1), cB + hstepB, voffB); PG8_STAGE(PG8_SA(0, 0), cA, voffA); PG8_STAGE(PG8_SA(0, 1), cA + hstepA, voffA);
    if (wr == 1) PG8_BAR;
    PG8_WAIT_V(2); PG8_BAR;
    PG8_STAGE(PG8_SB(1, 0), cB + kstep, voffB); PG8_STAGE(PG8_SA(1, 0), cA + kstep, voffA); PG8_STAGE(PG8_SB(1, 1), cB + hstepB + kstep, voffB);
    PG8_WAIT_V(6); PG8_BAR;
    for (;;) {
        const bool has_next = S.next(ui + 1, nxt);
        const char* nA = has_next ? (const char*)g.A + (size_t)nxt.pm * tstepA + (size_t)nxt.koff * 2 : cA;
        const char* nB = has_next ? (const char*)g.Bt + (size_t)nxt.pn * tstepB + (size_t)nxt.koff * 2 : cB;
        const int nt = cur.nt;
        for (int t = 0; t < nt; t += 2) {
            const bool last = (t == nt - 2);
            const char* a1 = cA + (size_t)(t + 1) * kstep;
            const char* a2 = last ? nA : cA + (size_t)(t + 2) * kstep; const char* b2 = last ? nB : cB + (size_t)(t + 2) * kstep;
            const char* a3 = a2 + kstep; const char* b3 = b2 + kstep;
            PG8_LDB(B0, 0, 0); PG8_LDB(B1, 0, 1); PG8_SCHED; PG8_LDA(At, 0, 0); PG8_STAGE(PG8_SA(1, 1), a1 + hstepA, voffA);
            PG8_WAIT_V(8); PG8_WAIT_L(0); PG8_BAR; PG8_MMA(0, 0, At, B0); PG8_MMA(0, 1, At, B1); PG8_BAR; PG8_SCHED;
            PG8_LDA(At, 0, 1); PG8_STAGE(PG8_SB(0, 0), b2, voffB); PG8_STAGE(PG8_SB(0, 1), b2 + hstepB, voffB); PG8_STAGE(PG8_SA(0, 0), a2, voffA);
            PG8_WAIT_V(8); PG8_WAIT_L(0); PG8_BAR; PG8_MMA(1, 0, At, B0); PG8_MMA(1, 1, At, B1); PG8_BAR; PG8_SCHED;
            PG8_LDB(B0, 1, 0); PG8_LDB(B1, 1, 1); PG8_SCHED; PG8_LDA(At, 1, 0); PG8_STAGE(PG8_SA(0, 1), a2 + hstepA, voffA);
            PG8_WAIT_V(8); PG8_WAIT_L(0); PG8_BAR; PG8_MMA(0, 0, At, B0); PG8_MMA(0, 1, At, B1); PG8_BAR; PG8_SCHED;
            PG8_LDA(At, 1, 1); PG8_STAGE(PG8_SB(1, 0), b3, voffB); PG8_STAGE(PG8_SB(1, 1), b3 + hstepB, voffB); PG8_STAGE(PG8_SA(1, 0), a3, voffA);
            PG8_WAIT_V(8); PG8_WAIT_L(0); PG8_BAR; PG8_MMA(1, 0, At, B0); PG8_MMA(1, 1, At, B1); PG8_BAR; PG8_SCHED;
        }
        if constexpr (ALIGN_EPI) { if (wr == 0) PG8_BAR; }
        E(acc, cur, wr, wc, fr, fq);
        if (!has_next) break;
        if (!(Epi::KEEP_ACC && nxt.seg != 0)) {
#pragma unroll
        for (int a = 0; a < 2; ++a)
#pragma unroll
            for (int b = 0; b < 2; ++b)
#pragma unroll
                for (int m = 0; m < 4; ++m)
#pragma unroll
                    for (int n = 0; n < 2; ++n) acc[a][b][m][n] = (f32x4){0.f, 0.f, 0.f, 0.f};
        }
        cur = nxt; cA = nA; cB = nB; ++ui;
        if constexpr (ALIGN_EPI) { if (wr == 1) PG8_BAR; }
    }
    PG8_WAIT_V(0);
    if constexpr (!ALIGN_EPI) { if (wr == 0) PG8_BAR; }
    PG8_BAR;
#undef PG8_SA
#undef PG8_SB
#undef PG8_STAGE
#undef PG8_LDA
#undef PG8_LDB
#undef PG8_MMA
#undef PG8_WAIT_V
#undef PG8_WAIT_L
#undef PG8_BAR
#undef PG8_SCHED
}
}

constexpr int NWAVES = 8, NTHREADS = 512;
constexpr int DM = 2048, NB = 4, SEQ = 2048, M = NB * SEQ, DEPTH = 2, DFF = 8192;
constexpr int NIN = 7936, NGATE = 6144, N1 = NIN + NGATE;
constexpr int OFF_AQ = 0, OFF_AF = 1024, OFF_AI = 2048, OFF_AG = 3072, OFF_BQ = 4096, OFF_BK = 4864, OFF_BV = 5632, OFF_CA = 6400, OFF_CG = 7168;
constexpr int YC_A = 0, YC_B = 1024, YC_C = 1280;
constexpr float EPS = 1e-6f;

constexpr size_t MiB = 1u << 20;
constexpr size_t WS_CTL = 0, CTL_ZERO_BYTES = 1 * MiB;
constexpr size_t WS_MOD = 1 * MiB;
constexpr size_t WS_LB = WS_MOD + 512 * 1024;
constexpr size_t WS_BIAS = WS_LB + 16 * 1024;
constexpr size_t WS_W = 2 * MiB, W_LAYER = 135 * MiB;
constexpr size_t WO_CAT1 = 0, WO_CAT2 = 55 * MiB, WO_O = 63 * MiB, WO_UP = 71 * MiB, WO_DOWN = 103 * MiB;
constexpr size_t WS_H = 272 * MiB;
constexpr size_t WS_INP = 304 * MiB;
constexpr size_t WS_GATES = 428 * MiB;
constexpr size_t WS_U = WS_INP;
constexpr size_t WS_YCAT = 524 * MiB;
constexpr size_t WS_MPART = 556 * MiB;
constexpr size_t WS_Y = WS_MPART;
constexpr size_t WS_MERGED = 620 * MiB;
constexpr size_t WS_ATTO = 652 * MiB;
constexpr size_t WS_ATTL = 676 * MiB;
constexpr size_t WS_HDEC = 676 * MiB + 512 * 1024;
constexpr size_t WS_HSTATE = WS_MPART;
constexpr size_t WS_END = 677 * MiB;

constexpr int G1_GEMM_CUS = 220;
constexpr int LDS_BYTES = 147456;
constexpr int RING_OFF = 0, MISC_OFF = LDS_BYTES - 256;

#define GAS __attribute__((address_space(1)))
#define LAS __attribute__((address_space(3)))
typedef unsigned short bf16;
typedef unsigned v4u __attribute__((ext_vector_type(4)));
typedef unsigned v2u __attribute__((ext_vector_type(2)));
typedef float f32x4 __attribute__((ext_vector_type(4)));
typedef float f32x2 __attribute__((ext_vector_type(2)));
typedef GAS unsigned gu32;
#define RLX_AGENT __ATOMIC_RELAXED, __HIP_MEMORY_SCOPE_AGENT
#define LDS_WAIT() asm volatile("s_waitcnt lgkmcnt(0)" ::: "memory")
__device__ __forceinline__ unsigned f2bf(float f) { unsigned u = __builtin_bit_cast(unsigned, f); return (u + 0x7fffu + ((u >> 16) & 1u)) >> 16; }
typedef __bf16 bf16x2_t __attribute__((ext_vector_type(2)));
__device__ __forceinline__ unsigned pk2(float lo, float hi) { bf16x2_t v; v[0] = (__bf16)lo; v[1] = (__bf16)hi; return __builtin_bit_cast(unsigned, v); }
__device__ __forceinline__ float bf2f(bf16 b) { return __uint_as_float(((unsigned)b) << 16); }
__device__ __forceinline__ float bflo(unsigned w) { return __uint_as_float(w << 16); }
__device__ __forceinline__ float bfhi(unsigned w) { return __uint_as_float(w & 0xffff0000u); }
__device__ __forceinline__ float sigm(float x) { return __builtin_amdgcn_rcpf(1.0f + __expf(-x)); }

#define XB_TMO      128
#define XB_XCNT(j)  (256  + 64 * (j))
#define XB_XSUB(j)  (1280 + 64 * (j))
#define XB_XGEN(j)  (2304 + 64 * (j))
#define XB_TOP      3328
#define XB_TOPGEN   3392
#define XCD_BAR_WORDS 3456
#define XB_SPIN_CAP (1u << 22)
__device__ __forceinline__ unsigned xb_ld(unsigned* p)              { return __hip_atomic_load(p, __ATOMIC_RELAXED, __HIP_MEMORY_SCOPE_AGENT); }
__device__ __forceinline__ unsigned xb_add(unsigned* p, unsigned v) { return __hip_atomic_fetch_add(p, v, __ATOMIC_RELAXED, __HIP_MEMORY_SCOPE_AGENT); }
__device__ __forceinline__ unsigned xb_xcc_id() { return (unsigned)__builtin_amdgcn_s_getreg((3 << 11) | 20) & 0xFu; }
#define XB_SPIN(cond, bar) do { unsigned _sp = 0; while (cond) { __builtin_amdgcn_s_sleep(1); \
    if ((++_sp & 255u) == 0u) { if (xb_ld(&(bar)[XB_TMO])) break; if (_sp > XB_SPIN_CAP) { atomicAdd(&(bar)[XB_TMO], 1u); break; } } } } while (0)
struct XcdBarrier { unsigned* bar; unsigned x; volatile LAS unsigned* st; };
__device__ __forceinline__ XcdBarrier xcd_barrier_post(unsigned* bar, volatile LAS unsigned* st) {
    XcdBarrier b; b.bar = bar; b.x = xb_xcc_id(); b.st = st;
    if (threadIdx.x == 0) (void)xb_add(&bar[XB_XCNT(b.x)], 1u);
    return b;
}
__device__ __forceinline__ void xcd_barrier_complete(unsigned* bar, unsigned x, unsigned& nloc, unsigned& nx) {
    const unsigned G = gridDim.x * gridDim.y * gridDim.z;
    unsigned sum, cnt, mine, sp = 0u;
    for (;;) {
        sum = 0u; cnt = 0u; mine = 0u;
#pragma unroll
        for (unsigned j = 0; j < 16; ++j) { const unsigned c = xb_ld(&bar[XB_XCNT(j)]); sum += c; cnt += (c > 0u) ? 1u : 0u; mine = (j == x) ? c : mine; }
        if (sum == G) break;
        __builtin_amdgcn_s_sleep(1);
        if ((++sp & 255u) == 0u) { if (xb_ld(&bar[XB_TMO])) break; if (sp > XB_SPIN_CAP) { atomicAdd(&bar[XB_TMO], 1u); break; } }
    }
    nloc = mine > 0u ? mine : 1u; nx = cnt > 0u ? cnt : 1u;
}
__device__ __forceinline__ void xcd_barrier(const XcdBarrier& b) {
    asm volatile("s_waitcnt vmcnt(0)" ::: "memory");
    __syncthreads();
    if (threadIdx.x == 0) {
        unsigned* bar = b.bar;
        __builtin_amdgcn_s_waitcnt(0);
        unsigned nloc = b.st[0], nx = b.st[1];
        if (nloc == 0u) { xcd_barrier_complete(bar, b.x, nloc, nx); b.st[0] = nloc; b.st[1] = nx; }
        const unsigned old = xb_add(&bar[XB_XSUB(b.x)], 1u);
        const unsigned gen = old / nloc;
        if (old + 1u == (gen + 1u) * nloc) {
            __builtin_amdgcn_fence(__ATOMIC_RELEASE, "agent");
            asm volatile("s_waitcnt vmcnt(0)" ::: "memory");
            const unsigned og = xb_add(&bar[XB_TOP], 1u);
            const unsigned tg = og / nx;
            if (og + 1u == (tg + 1u) * nx) xb_add(&bar[XB_TOPGEN], 1u);
            else XB_SPIN(xb_ld(&bar[XB_TOPGEN]) == tg, bar);
            __builtin_amdgcn_fence(__ATOMIC_ACQUIRE, "agent");
            xb_add(&bar[XB_XGEN(b.x)], 1u);
            asm volatile("s_waitcnt vmcnt(0)" ::: "memory");
        } else {
            XB_SPIN(xb_ld(&bar[XB_XGEN(b.x)]) == gen, bar);
            __builtin_amdgcn_fence(__ATOMIC_ACQUIRE, "agent");
            asm volatile("s_waitcnt vmcnt(0)" ::: "memory");
        }
    }
    __syncthreads();
}

struct Args { const float* in[24]; float* out; unsigned char* ws; int ph_lo, ph_hi; };
enum { IN_X = 0, IN_C, IN_RELB, IN_LBL, IN_WADA, IN_BADA, IN_NPRE, IN_NPOST, IN_WIN, IN_WGATE, IN_BGATE, IN_HNW, IN_CW, IN_CB, IN_CLG, IN_CLB,
       IN_WA, IN_WB, IN_WC, IN_WO, IN_MPRE, IN_MPOST, IN_WUP, IN_WDOWN };

struct Frame {
    LAS unsigned char* lds;
    int tid, lane, wave, G, bid;
    const Args* a;
    unsigned char* ws;
};

__device__ __forceinline__ float dpp_add(float v, const int ctrl_sel) {
    int x;
    if (ctrl_sel == 0) x = __builtin_amdgcn_update_dpp(0, __float_as_int(v), 0xB1, 0xf, 0xf, false);
    else if (ctrl_sel == 1) x = __builtin_amdgcn_update_dpp(0, __float_as_int(v), 0x4E, 0xf, 0xf, false);
    else if (ctrl_sel == 2) x = __builtin_amdgcn_update_dpp(0, __float_as_int(v), 0x141, 0xf, 0xf, false);
    else x = __builtin_amdgcn_update_dpp(0, __float_as_int(v), 0x140, 0xf, 0xf, false);
    return v + __int_as_float(x);
}
__device__ __forceinline__ float wave_sum(float v) {
    v = dpp_add(v, 0); v = dpp_add(v, 1); v = dpp_add(v, 2); v = dpp_add(v, 3);
    const float s0 = __int_as_float(__builtin_amdgcn_readlane(__float_as_int(v), 0)), s1 = __int_as_float(__builtin_amdgcn_readlane(__float_as_int(v), 16));
    const float s2 = __int_as_float(__builtin_amdgcn_readlane(__float_as_int(v), 32)), s3 = __int_as_float(__builtin_amdgcn_readlane(__float_as_int(v), 48));
    return (s0 + s1) + (s2 + s3);
}

struct TrItem { const float* src; bf16* dst; int N, ldt; };
__device__ __forceinline__ void tr_load(const TrItem& t, f32x4 (&v)[16], int lane) {
    const float* src = t.src + (size_t)(16 * (lane >> 4)) * t.N + 4 * (lane & 15);
#pragma unroll
    for (int i = 0; i < 16; ++i) v[i] = __builtin_nontemporal_load((const GAS f32x4*)(src + (size_t)i * t.N));
}
__device__ __forceinline__ void tr_finish(const TrItem& t, const f32x4 (&v)[16], LAS unsigned char* scr, int lane) {
    const int q = lane >> 4, p = lane & 15;
#pragma unroll
    for (int c = 0; c < 4; ++c) {
        v4u lo, hi;
        lo.x = pk2(v[0][c], v[1][c]); lo.y = pk2(v[2][c], v[3][c]); lo.z = pk2(v[4][c], v[5][c]); lo.w = pk2(v[6][c], v[7][c]);
        hi.x = pk2(v[8][c], v[9][c]); hi.y = pk2(v[10][c], v[11][c]); hi.z = pk2(v[12][c], v[13][c]); hi.w = pk2(v[14][c], v[15][c]);
        LAS unsigned char* d = scr + (4 * p + c) * 144 + q * 32;
        *(LAS v4u*)d = lo; *(LAS v4u*)(d + 16) = hi; }
    LDS_WAIT(); asm volatile("" ::: "memory");
#pragma unroll
    for (int j = 0; j < 8; ++j) { const int n = (lane >> 3) + 8 * j, ch = lane & 7;
        const v4u o = *(const LAS v4u*)(scr + n * 144 + ch * 16);
        *(GAS v4u*)(t.dst + (size_t)n * t.ldt + 8 * ch) = o; }
    LDS_WAIT(); asm volatile("" ::: "memory");
}

constexpr int TR_IN = 32 * 124, TR_GATE = 32 * 96, TR_A = 16 * 32, TR_B = 4 * 32, TR_C = 12 * 32, TR_O = 32 * 32, TR_UP = 32 * 128, TR_DOWN = 128 * 32;
constexpr int TR_PER_LAYER = TR_IN + TR_GATE + TR_A + TR_B + TR_C + TR_O + TR_UP + TR_DOWN, TR_FIRST = TR_IN + TR_GATE;
constexpr int PREP_ITEMS = (G1_GEMM_CUS < 256) ? TR_FIRST : 2 * TR_PER_LAYER;
__device__ __forceinline__ TrItem tr_decode(Frame& F, int it) {
    const Args& A = *F.a;
    const int l = it / TR_PER_LAYER; int r = it % TR_PER_LAYER;
    unsigned char* wl = F.ws + WS_W + (size_t)l * W_LAYER;
    const float* W; int N, ldt, row_off = 0, col_off = 0; bf16* WT;
    if (r < TR_IN) { W = A.in[IN_WIN] + (size_t)l * 2048 * NIN; N = NIN; WT = (bf16*)(wl + WO_CAT1); ldt = 2048; }
    else if ((r -= TR_IN) < TR_GATE) { W = A.in[IN_WGATE] + (size_t)l * 2048 * NGATE; N = NGATE; WT = (bf16*)(wl + WO_CAT1); ldt = 2048; row_off = NIN; }
    else if ((r -= TR_GATE) < TR_A) { W = A.in[IN_WA] + (size_t)l * 1024 * 2048; N = 2048; WT = (bf16*)(wl + WO_CAT2); ldt = 2048; }
    else if ((r -= TR_A) < TR_B) { W = A.in[IN_WB] + (size_t)l * 256 * 2048; N = 2048; WT = (bf16*)(wl + WO_CAT2); ldt = 2048; col_off = 1024; }
    else if ((r -= TR_B) < TR_C) { W = A.in[IN_WC] + (size_t)l * 768 * 2048; N = 2048; WT = (bf16*)(wl + WO_CAT2); ldt = 2048; col_off = 1280; }
    else if ((r -= TR_C) < TR_O) { W = A.in[IN_WO] + (size_t)l * 2048 * 2048; N = 2048; WT = (bf16*)(wl + WO_O); ldt = 2048; }
    else if ((r -= TR_O) < TR_UP) { W = A.in[IN_WUP] + (size_t)l * 2048 * 8192; N = 8192; WT = (bf16*)(wl + WO_UP); ldt = 2048; }
    else { r -= TR_UP; W = A.in[IN_WDOWN] + (size_t)l * 8192 * 2048; N = 2048; WT = (bf16*)(wl + WO_DOWN); ldt = 8192; }
    const int nblk = N / 64, kb = r / nblk, nb = r % nblk;
    int drow = row_off + 64 * nb;
    if (N == NIN && 64 * nb >= OFF_CA) {
        const int isg = (64 * nb >= OFF_CG) ? 1 : 0, ch = 64 * nb - (isg ? OFF_CG : OFF_CA);
        drow = OFF_CA + 256 * (ch >> 7) + 128 * isg + (ch & 127); }
    TrItem t; t.src = W + (size_t)(64 * kb) * N + 64 * nb; t.dst = WT + (size_t)drow * ldt + col_off + 64 * kb; t.N = N; t.ldt = ldt; return t;
}
__device__ __forceinline__ void transposes(Frame& F, int gw, int ngw, int lo_item, int hi_item) {
    LAS unsigned char* scr = F.lds + F.wave * 16384;
    for (int it = lo_item + gw; it < hi_item; it += 2 * ngw) {
        const bool two = (it + ngw) < hi_item;
        const TrItem t0 = tr_decode(F, it), t1 = tr_decode(F, two ? it + ngw : it);
        f32x4 v0[16], v1[16];
        tr_load(t0, v0, F.lane); if (two) tr_load(t1, v1, F.lane);
        tr_finish(t0, v0, scr, F.lane); if (two) tr_finish(t1, v1, scr, F.lane);
    }
}

__device__ __forceinline__ void gemv_items(Frame& F, int first, int last, int cb, int ncb) {
    const Args& A = *F.a;
    float* MOD = (float*)(F.ws + WS_MOD);
    LAS float* cact = (LAS float*)(F.lds);
    LAS float* red = (LAS float*)(F.lds + 32768);
    __syncthreads();
    for (int e = F.tid; e < 4 * 2048; e += NTHREADS) { const float c = A.in[IN_C][e]; cact[e] = c * sigm(c); }
    __syncthreads();
    for (int it = first + cb; it < last; it += ncb) {
        const int l = it / 384, cg = it % 384, c4 = F.tid & 7, kk = F.tid >> 3;
        const float* W = A.in[IN_WADA] + (size_t)l * 2048 * 12288 + cg * 32 + c4 * 4;
        float acc[4][4];
#pragma unroll
        for (int b = 0; b < 4; ++b)
#pragma unroll
            for (int j = 0; j < 4; ++j) acc[b][j] = 0.f;
#pragma unroll 1
        for (int k0 = kk; k0 < 2048; k0 += 64 * 16) {
            f32x4 wv[16];
#pragma unroll
            for (int u = 0; u < 16; ++u) wv[u] = __builtin_nontemporal_load((const GAS f32x4*)(W + (size_t)(k0 + 64 * u) * 12288));
#pragma unroll
            for (int u = 0; u < 16; ++u) {
#pragma unroll
                for (int b = 0; b < 4; ++b) { const float cv = cact[b * 2048 + k0 + 64 * u];
#pragma unroll
                    for (int j = 0; j < 4; ++j) acc[b][j] += cv * wv[u][j]; } }
        }
#pragma unroll
        for (int b = 0; b < 4; ++b)
#pragma unroll
            for (int j = 0; j < 4; ++j) red[(kk * 8 + c4) * 16 + b * 4 + j] = acc[b][j];
        __syncthreads();
        if (F.tid < 128) { const int b = F.tid >> 5, col = F.tid & 31, cc4 = col >> 2, j = col & 3; float sacc = 0.f;
            for (int q = 0; q < 64; ++q) sacc += red[(q * 8 + cc4) * 16 + b * 4 + j];
            MOD[((size_t)l * 4 + b) * 12288 + cg * 32 + col] = sacc + A.in[IN_BADA][l * 12288 + cg * 32 + col]; }
        __syncthreads();
    }
}
#ifndef GEMV_FIRST_ITEMS
#define GEMV_FIRST_ITEMS 768
#endif
constexpr int GEMV_FIRST = GEMV_FIRST_ITEMS, GEMV_ALL = 768;
__device__ __forceinline__ void prep_phase(Frame& F) {
    const Args& A = *F.a;
    float* LB = (float*)(F.ws + WS_LB); float* BT = (float*)(F.ws + WS_BIAS);
    gemv_items(F, 0, (G1_GEMM_CUS < 256) ? GEMV_FIRST : GEMV_ALL, F.bid, F.G);
    if (F.bid == F.G - 1) {
        for (int k = F.tid; k < 1024; k += NTHREADS) {
            const float a0 = A.in[IN_LBL][k], a1 = A.in[IN_LBL][1024 + k], mx = fmaxf(a0, a1), e0 = expf(a0 - mx), e1 = expf(a1 - mx), s0 = e0 / (e0 + e1), s1 = e1 / (e0 + e1);
            LB[k] = fmaxf(s0 - s0, 0.f); LB[1024 + k] = fmaxf((s0 + s1) - s0, 0.f);
        }
        for (int e = F.tid; e < 3 * 4 * 129; e += NTHREADS) {
            const int g = e / (4 * 129), r = e % (4 * 129), sl = r / 129, j = r % 129; const int dil = g == 0 ? 1 : (g == 1 ? 4 : 16);
            const int dist = j * dil; int bucket;
            if (dist < 16) bucket = dist; else { const float dd = (float)dist; int large = 16 + (int)(logf(dd / 16.0f) / logf(128.0f) * 16.0f); bucket = large < 16 ? 16 : (large > 31 ? 31 : large); }
            BT[(g * 4 + sl) * 132 + j] = A.in[IN_RELB][bucket * 12 + g * 4 + sl];
        }
    }
    __syncthreads();
    transposes(F, F.bid * NWAVES + F.wave, F.G * NWAVES, 0, PREP_ITEMS);
}

__device__ __forceinline__ void norm_phase(Frame& F, const float* xin, float* xout, const bf16* y, const float* g  , const float* wpost,
                                           const float* wpre, const float* sc, const float* sh, bf16* H) {
    const int gw = F.bid * NWAVES + F.wave, NGW = F.G * NWAVES;
    for (int m0 = 2 * gw; m0 < M; m0 += 2 * NGW) {
        const int b = m0 / SEQ;
        f32x4 v[2][8]; v4u yw[2][4];
#pragma unroll
        for (int r = 0; r < 2; ++r) { const GAS f32x4* xr = (const GAS f32x4*)(xin + (size_t)(m0 + r) * DM) + 2 * F.lane;
#pragma unroll
            for (int j = 0; j < 4; ++j) { v[r][2 * j] = xr[128 * j]; v[r][2 * j + 1] = xr[128 * j + 1]; }
            if (y) { const GAS v4u* yr = (const GAS v4u*)(y + (size_t)(m0 + r) * DM) + F.lane;
#pragma unroll
                for (int j = 0; j < 4; ++j) yw[r][j] = yr[64 * j]; } }
#pragma unroll
        for (int r = 0; r < 2; ++r) {
            const int m = m0 + r;
            if (y) {
                f32x4 yv[8]; float ss = 0.f;
#pragma unroll
                for (int j = 0; j < 4; ++j) { const v4u w = yw[r][j]; yv[2 * j] = (f32x4){bflo(w.x), bfhi(w.x), bflo(w.y), bfhi(w.y)}; yv[2 * j + 1] = (f32x4){bflo(w.z), bfhi(w.z), bflo(w.w), bfhi(w.w)}; }
#pragma unroll
                for (int j = 0; j < 8; ++j) ss += (yv[j].x * yv[j].x + yv[j].y * yv[j].y) + (yv[j].z * yv[j].z + yv[j].w * yv[j].w);
                const float rr = __builtin_amdgcn_rsqf(wave_sum(ss) * (1.0f / DM) + EPS);
#pragma unroll
                for (int j = 0; j < 8; ++j) { const int col = 8 * F.lane + 512 * (j >> 1) + 4 * (j & 1);
                    const f32x4 gg = *(const GAS f32x4*)(g + (size_t)b * 12288 + col), wp = *(const GAS f32x4*)(wpost + col);
                    v[r][j] = v[r][j] + gg * (yv[j] * rr * wp); }
            }
            if (xout) { GAS f32x4* xo = (GAS f32x4*)(xout + (size_t)m * DM) + 2 * F.lane;
#pragma unroll
                for (int j = 0; j < 4; ++j) { xo[128 * j] = v[r][2 * j]; xo[128 * j + 1] = v[r][2 * j + 1]; } }
            if (wpre) {
                float ss = 0.f;
#pragma unroll
                for (int j = 0; j < 8; ++j) ss += (v[r][j].x * v[r][j].x + v[r][j].y * v[r][j].y) + (v[r][j].z * v[r][j].z + v[r][j].w * v[r][j].w);
                const float rr = __builtin_amdgcn_rsqf(wave_sum(ss) * (1.0f / DM) + EPS);
                GAS v4u* ho = (GAS v4u*)(H + (size_t)m * DM) + F.lane;
#pragma unroll
                for (int j = 0; j < 4; ++j) { const int col = 8 * F.lane + 512 * j; v4u o;
                    { const f32x4 wp = *(const GAS f32x4*)(wpre + col), s1 = *(const GAS f32x4*)(sc + (size_t)b * 12288 + col), s0 = *(const GAS f32x4*)(sh + (size_t)b * 12288 + col);
                      const f32x4 h = (v[r][2 * j] * rr * wp) * (s1 + 1.0f) + s0; o.x = pk2(h.x, h.y); o.y = pk2(h.z, h.w); }
                    { const f32x4 wp = *(const GAS f32x4*)(wpre + col + 4), s1 = *(const GAS f32x4*)(sc + (size_t)b * 12288 + col + 4), s0 = *(const GAS f32x4*)(sh + (size_t)b * 12288 + col + 4);
                      const f32x4 h = (v[r][2 * j + 1] * rr * wp) * (s1 + 1.0f) + s0; o.z = pk2(h.x, h.y); o.w = pk2(h.z, h.w); }
                    ho[64 * j] = o; }
            }
        }
    }
}

__device__ __forceinline__ void conv_phase(Frame& F, int l, bf16* YC) {
    const Args& A = *F.a;
    const bf16* INP = (const bf16*)(F.ws + WS_INP);
    const float* CW = A.in[IN_CW] + (size_t)l * 31 * 768; const float* CB = A.in[IN_CB] + l * 768; const float* LG = A.in[IN_CLG] + l * 768; const float* LBt = A.in[IN_CLB] + l * 768;
    LAS float* U = (LAS float*)(F.lds);
    LAS float* red = (LAS float*)(F.lds + 46 * 768 * 4);
    LAS float* fin = red + 6 * 32;
    for (int it = F.bid; it < 512; it += F.G) {
        const int b = it >> 7, t0 = (it & 127) * 16;
        __syncthreads();
#pragma unroll 1
        for (int q0 = 0; q0 < 9; q0 += 3) {
            v4u aw[3];
#pragma unroll
            for (int q = 0; q < 3; ++q) { const int e = F.tid + (q0 + q) * NTHREADS, r = e / 96, c8 = (e - r * 96) * 8, t = t0 - 30 + r;
                aw[q] = (v4u){0u, 0u, 0u, 0u};
                if (e < 46 * 96 && t >= 0) aw[q] = *(const GAS v4u*)(INP + ((size_t)b * SEQ + t) * NIN + OFF_CA + c8); }
#pragma unroll
            for (int q = 0; q < 3; ++q) { const int e = F.tid + (q0 + q) * NTHREADS, r = e / 96, c8 = (e - r * 96) * 8;
                if (e < 46 * 96) { const f32x4 u0 = (f32x4){bflo(aw[q].x), bfhi(aw[q].x), bflo(aw[q].y), bfhi(aw[q].y)}, u1 = (f32x4){bflo(aw[q].z), bfhi(aw[q].z), bflo(aw[q].w), bfhi(aw[q].w)};
                    *(LAS f32x4*)(U + r * 768 + c8) = u0; *(LAS f32x4*)(U + r * 768 + c8 + 4) = u1; } }
        }
        __syncthreads();
        const bool act = F.tid < 384; const int c0 = act ? 2 * F.tid : 0;
        float acc[16][2];
        {
            float w[31][2];
#pragma unroll
            for (int j = 0; j < 31; ++j) { w[j][0] = CW[j * 768 + c0]; w[j][1] = CW[j * 768 + c0 + 1]; }
            const float b0 = CB[c0], b1 = CB[c0 + 1];
#pragma unroll
            for (int tt = 0; tt < 16; ++tt) { acc[tt][0] = b0; acc[tt][1] = b1; }
#pragma unroll
            for (int r = 0; r < 46; ++r) {
                const float u0 = U[r * 768 + c0], u1 = U[r * 768 + c0 + 1];
#pragma unroll
                for (int tt = 0; tt < 16; ++tt) { const int j = r - tt; if (j >= 0 && j <= 30) { acc[tt][0] += u0 * w[j][0]; acc[tt][1] += u1 * w[j][1]; } }
            }
        }
#pragma unroll
        for (int tt = 0; tt < 16; ++tt) {
            float sv = act ? (acc[tt][0] + acc[tt][1]) : 0.f, qv = act ? (acc[tt][0] * acc[tt][0] + acc[tt][1] * acc[tt][1]) : 0.f;
            sv = wave_sum(sv); qv = wave_sum(qv);
            if (F.lane == 0 && F.wave < 6) { red[F.wave * 32 + tt] = sv; red[F.wave * 32 + 16 + tt] = qv; }
        }
        __syncthreads();
        if (F.tid < 16) { float ts = 0.f, tq = 0.f;
#pragma unroll
            for (int w = 0; w < 6; ++w) { ts += red[w * 32 + F.tid]; tq += red[w * 32 + 16 + F.tid]; }
            const float mu = ts * (1.0f / 768.f), var = tq * (1.0f / 768.f) - mu * mu;
            fin[F.tid * 2] = mu; fin[F.tid * 2 + 1] = __builtin_amdgcn_rsqf(var + EPS); }
        __syncthreads();
        if (act) { int c0v = c0; asm volatile("" : "+v"(c0v));
            const float g0 = LG[c0v], g1 = LG[c0v + 1], bb0 = LBt[c0v], bb1 = LBt[c0v + 1];
            GAS unsigned* op = (GAS unsigned*)(YC + ((size_t)b * SEQ + t0) * DM + YC_C + c0v);
#pragma unroll
            for (int tt = 0; tt < 16; ++tt) { const f32x2 mr = *(const LAS f32x2*)(fin + tt * 2);
                const float a0 = (acc[tt][0] - mr.x) * mr.y * g0 + bb0, a1 = (acc[tt][1] - mr.x) * mr.y * g1 + bb1;
                op[tt * (DM / 2)] = pk2(a0 * sigm(a0), a1 * sigm(a1)); } }
    }
}

typedef short s16x4 __attribute__((ext_vector_type(4)));
typedef short s16x8 __attribute__((ext_vector_type(8)));
constexpr int ATT_KS = 144, ATT_VS = 160;
constexpr int ATT_K_OFF = 0, ATT_V_OFF = 256 * ATT_KS, ATT_B_OFF = ATT_V_OFF + 272 * ATT_VS;
typedef short v4i16_t __attribute__((ext_vector_type(4)));
__device__ __forceinline__ s16x4 lds_tr16(LAS unsigned char* p) { return __builtin_bit_cast(s16x4, __builtin_amdgcn_ds_read_tr16_b64_v4i16((LAS v4i16_t*)p)); }
struct AttItem { int g, b, s, r, qb, head, dil; };
__device__ __forceinline__ AttItem att_decode(int it) {
    AttItem a; a.g = it >> 8; const int rem = it & 255; a.b = rem >> 6; a.s = (rem >> 4) & 3; const int rq = rem & 15;
    const int dsh = 2 * a.g, nqbsh = 4 - dsh; a.dil = 1 << dsh;
    a.r = rq >> nqbsh; a.qb = rq & ((1 << nqbsh) - 1); a.head = 4 * a.g + a.s; return a;
}
__device__ __forceinline__ void att_load(Frame& F, const AttItem& a, v4u (&kv)[4], v4u (&vv)[4], v4u (&qv)[2], float& bs) {
    const bf16* INP = (const bf16*)(F.ws + WS_INP); const float* BT = (const float*)(F.ws + WS_BIAS);
#pragma unroll
    for (int i = 0; i < 4; ++i) { const int row = (F.tid >> 3) + 64 * i, ch = F.tid & 7; const int lp = 128 * (a.qb - 1) + row;
        kv[i] = (v4u){0u, 0u, 0u, 0u}; vv[i] = kv[i];
        if (lp >= 0) { const size_t ro = ((size_t)a.b * SEQ + (size_t)lp * a.dil + a.r) * NIN + a.head * 64 + ch * 8;
            kv[i] = *(const GAS v4u*)(INP + ro + OFF_BK); vv[i] = *(const GAS v4u*)(INP + ro + OFF_BV); } }
    const int lq = 128 * a.qb + 16 * F.wave + (F.lane & 15); const size_t qrow = (size_t)a.b * SEQ + (size_t)lq * a.dil + a.r;
#pragma unroll
    for (int ks = 0; ks < 2; ++ks) qv[ks] = *(const GAS v4u*)(INP + qrow * NIN + OFF_BQ + a.head * 64 + ks * 32 + (F.lane >> 4) * 8);
    bs = (F.tid < 129) ? BT[(a.g * 4 + a.s) * 132 + F.tid] : 0.f;
}
__device__ __forceinline__ void attn_phase(Frame& F) {
    float* AO = (float*)(F.ws + WS_ATTO); float* AL = (float*)(F.ws + WS_ATTL);
    LAS unsigned char* Ks = F.lds + ATT_K_OFF; LAS unsigned char* Vs = F.lds + ATT_V_OFF; LAS float* Bs = (LAS float*)(F.lds + ATT_B_OFF);
    const int w = F.wave, qcol = F.lane & 15, g4 = F.lane >> 4;
    int it = F.bid;
    if (it >= 768) return;
    AttItem cur = att_decode(it);
    v4u kvr[4], vvr[4], qvr[2]; float bsr;
    att_load(F, cur, kvr, vvr, qvr, bsr);
    for (; it < 768; it += F.G) {
        const int g = cur.g, b = cur.b, s = cur.s, r = cur.r, qb = cur.qb, dil = cur.dil;
        __syncthreads();
#pragma unroll
        for (int i = 0; i < 4; ++i) { const int row = (F.tid >> 3) + 64 * i, ch = F.tid & 7;
            *(LAS v4u*)(Ks + row * ATT_KS + ch * 16) = kvr[i]; *(LAS v4u*)(Vs + row * ATT_VS + ch * 16) = vvr[i]; }
        if (F.tid < 128) *(LAS v4u*)(Vs + (256 + (F.tid >> 3)) * ATT_VS + (F.tid & 7) * 16) = (v4u){0u, 0u, 0u, 0u};
        if (F.tid < 129) Bs[F.tid] = bsr;
        const int lq = 128 * qb + 16 * w + qcol; const size_t qrow = (size_t)b * SEQ + (size_t)lq * dil + r;
        s16x8 qf[2];
#pragma unroll
        for (int ks = 0; ks < 2; ++ks) qf[ks] = __builtin_bit_cast(s16x8, qvr[ks]);
        __syncthreads();
        if (it + F.G < 768) { cur = att_decode(it + F.G); att_load(F, cur, kvr, vvr, qvr, bsr); }
        float sc[9][4];
#pragma unroll
        for (int i = 0; i < 9; ++i) {
            pg8::f32x4 a4 = (pg8::f32x4){0.f, 0.f, 0.f, 0.f};
#pragma unroll
            for (int ks = 0; ks < 2; ++ks) { const s16x8 kf = *(const LAS s16x8*)(Ks + (16 * (w + i) + qcol) * ATT_KS + ks * 64 + g4 * 16);
                a4 = __builtin_amdgcn_mfma_f32_16x16x32_bf16(kf, qf[ks], a4, 0, 0, 0); }
#pragma unroll
            for (int rg = 0; rg < 4; ++rg) { const int keyrow = 4 * g4 + rg; const int j = 128 - 16 * i + qcol - keyrow;
                const int lp = 128 * (qb - 1) + 16 * (w + i) + keyrow;
                const bool valid = (j >= 0) && (j <= 128) && (lp >= 0);
                const float bias = Bs[valid ? j : 0];
                sc[i][rg] = valid ? (a4[rg] * 0.125f + bias) : -1e30f; }
        }
        float mx = -1e30f;
#pragma unroll
        for (int i = 0; i < 9; ++i)
#pragma unroll
            for (int rg = 0; rg < 4; ++rg) mx = fmaxf(mx, sc[i][rg]);
        mx = fmaxf(mx, __shfl_xor(mx, 16)); mx = fmaxf(mx, __shfl_xor(mx, 32));
        float z = 0.f; unsigned pp[10][2];
#pragma unroll
        for (int i = 0; i < 9; ++i) { float p[4];
#pragma unroll
            for (int rg = 0; rg < 4; ++rg) { p[rg] = __expf(sc[i][rg] - mx); z += p[rg]; }
            pp[i][0] = pk2(p[0], p[1]); pp[i][1] = pk2(p[2], p[3]); }
        pp[9][0] = 0u; pp[9][1] = 0u;
        z += __shfl_xor(z, 16); z += __shfl_xor(z, 32);
        pg8::f32x4 oa[4];
#pragma unroll
        for (int dt = 0; dt < 4; ++dt) oa[dt] = (pg8::f32x4){0.f, 0.f, 0.f, 0.f};
#pragma unroll
        for (int c = 0; c < 5; ++c) {
            v4u pw; pw.x = pp[2 * c][0]; pw.y = pp[2 * c][1]; pw.z = pp[2 * c + 1][0]; pw.w = pp[2 * c + 1][1];
            const s16x8 pf = __builtin_bit_cast(s16x8, pw);
#pragma unroll
            for (int dt = 0; dt < 4; ++dt) {
                LAS unsigned char* va = Vs + (16 * (w + 2 * c) + 4 * g4 + (qcol >> 2)) * ATT_VS + (16 * dt + 4 * (qcol & 3)) * 2;
                const s16x4 v0 = lds_tr16(va), v1 = lds_tr16(va + 16 * ATT_VS);
                const s16x8 vf = (s16x8){v0[0], v0[1], v0[2], v0[3], v1[0], v1[1], v1[2], v1[3]};
                oa[dt] = __builtin_amdgcn_mfma_f32_16x16x32_bf16(vf, pf, oa[dt], 0, 0, 0);
            }
        }
        const float iz = 1.0f / z;
        float* op = AO + ((size_t)g * M + qrow) * 256 + s * 64 + 4 * g4;
#pragma unroll
        for (int dt = 0; dt < 4; ++dt) *(GAS f32x4*)(op + 16 * dt) = oa[dt] * iz;
        if (g4 == 0) AL[((size_t)g * M + qrow) * 4 + s] = mx + __logf(z);
    }
}
__device__ __forceinline__ void attn_combine_phase(Frame& F, bf16* YC) {
    const float* AO = (const float*)(F.ws + WS_ATTO); const float* AL = (const float*)(F.ws + WS_ATTL);
    for (int id = F.bid * NTHREADS + F.tid; id < M * 32; id += F.G * NTHREADS) {
        const int c8 = id & 31, row = id >> 5, s = c8 >> 3;
        const float l0 = AL[((size_t)0 * M + row) * 4 + s], l1 = AL[((size_t)1 * M + row) * 4 + s], l2 = AL[((size_t)2 * M + row) * 4 + s];
        const float mx = fmaxf(l0, fmaxf(l1, l2)); const float e0 = __expf(l0 - mx), e1 = __expf(l1 - mx), e2 = __expf(l2 - mx), inv = 1.0f / (e0 + e1 + e2);
        f32x4 a = (f32x4){0.f, 0.f, 0.f, 0.f}, bq = a;
        { const GAS f32x4* p = (const GAS f32x4*)(AO + ((size_t)0 * M + row) * 256 + c8 * 8); a = a + p[0] * (e0 * inv); bq = bq + p[1] * (e0 * inv); }
        { const GAS f32x4* p = (const GAS f32x4*)(AO + ((size_t)1 * M + row) * 256 + c8 * 8); a = a + p[0] * (e1 * inv); bq = bq + p[1] * (e1 * inv); }
        { const GAS f32x4* p = (const GAS f32x4*)(AO + ((size_t)2 * M + row) * 256 + c8 * 8); a = a + p[0] * (e2 * inv); bq = bq + p[1] * (e2 * inv); }
        v4u o; o.x = pk2(a.x, a.y); o.y = pk2(a.z, a.w); o.z = pk2(bq.x, bq.y); o.w = pk2(bq.z, bq.w);
        *(GAS v4u*)(YC + (size_t)row * DM + YC_B + c8 * 8) = o;
    }
}


constexpr int HG_QD = 0, HG_KINV = 17408, HG_KDT = 34816, HG_VS = 52224, HG_DEC = 70656, HG_O = 72704;
__device__ __forceinline__ s16x4 pack4(float a, float b, float c, float d) { v2u w; w.x = pk2(a, b); w.y = pk2(c, d); return __builtin_bit_cast(s16x4, w); }
template <bool OUT> __device__ __forceinline__ void hgrn_group_phase(Frame& F, int l, bf16* YC) {
    const Args& A = *F.a;
    const bf16* INP = (const bf16*)(F.ws + WS_INP);
    float* HS = (float*)(F.ws + WS_HSTATE); float* HD = (float*)(F.ws + WS_HDEC);
    const float* LB = (const float*)(F.ws + WS_LB) + l * 1024; const float* NW = A.in[IN_HNW] + l * 128;
    LAS unsigned char* QD = F.lds + HG_QD; LAS unsigned char* KINV = F.lds + HG_KINV; LAS unsigned char* KDT = F.lds + HG_KDT; LAS unsigned char* VS = F.lds + HG_VS;
    LAS float* DEC = (LAS float*)(F.lds + HG_DEC); LAS float* OB = (LAS float*)(F.lds + HG_O);
    const int w = F.wave, li = F.lane & 15, g4 = F.lane >> 4;
    const int pk = F.tid & 127, pi = F.tid >> 7;
    for (int it = F.bid; it < 256; it += F.G) {
        const int bh = it >> 3, grp = it & 7, b = bh >> 3, h = bh & 7;
        pg8::f32x4 R[8];
#pragma unroll
        for (int kb = 0; kb < 8; ++kb) R[kb] = (pg8::f32x4){0.f, 0.f, 0.f, 0.f};
        if (OUT && grp > 0) {
            const float* hs = HS + (size_t)(bh * 8) * 16384 + (size_t)(4 * g4) * 128 + 16 * w + li; const float* dj = HD + (size_t)(bh * 8) * 128 + 4 * g4;
            float nx[8][4]; f32x4 nd[8];
#pragma unroll
            for (int kb = 0; kb < 8; ++kb) { nd[kb] = *(const GAS f32x4*)(dj + 16 * kb);
#pragma unroll
                for (int rg = 0; rg < 4; ++rg) nx[kb][rg] = hs[(16 * kb + rg) * 128]; }
#pragma unroll 1
            for (int j = 0; j < grp; ++j) {
                float cx[8][4]; f32x4 cd[8];
#pragma unroll
                for (int kb = 0; kb < 8; ++kb) { cd[kb] = nd[kb];
#pragma unroll
                    for (int rg = 0; rg < 4; ++rg) cx[kb][rg] = nx[kb][rg]; }
                if (j + 1 < grp) { hs += 16384; dj += 128;
#pragma unroll
                    for (int kb = 0; kb < 8; ++kb) { nd[kb] = *(const GAS f32x4*)(dj + 16 * kb);
#pragma unroll
                        for (int rg = 0; rg < 4; ++rg) nx[kb][rg] = hs[(16 * kb + rg) * 128]; } }
#pragma unroll
                for (int kb = 0; kb < 8; ++kb)
#pragma unroll
                    for (int rg = 0; rg < 4; ++rg) R[kb][rg] = cd[kb][rg] * R[kb][rg] + cx[kb][rg];
            }
        }
        float decp = 1.0f;
        const float lbk = LB[h * 128 + pk];
#pragma unroll 1
        for (int c4 = 0; c4 < 4; ++c4) {
            const size_t row0 = (size_t)b * SEQ + 256 * grp + 64 * c4;
            __syncthreads();
#pragma unroll
            for (int i = 0; i < 2; ++i) { const int e = F.tid + 512 * i, r = e >> 4, ch = e & 15;
                *(LAS v4u*)(VS + r * 288 + ch * 16) = *(const GAS v4u*)(INP + (row0 + r) * NIN + OFF_AI + h * 128 + ch * 8); }
            {
                float c[16], kk[16], qs[16];
                bf16 zr[16], qr[16];
#pragma unroll
                for (int t = 0; t < 16; ++t) { const size_t ro = (row0 + 16 * pi + t) * NIN + h * 128 + pk; zr[t] = INP[ro + OFF_AF]; if (OUT) qr[t] = INP[ro + OFF_AQ]; }
                float run = 1.f;
#pragma unroll
                for (int t = 0; t < 16; ++t) { const float kt = (1.f - lbk) * bf2f(zr[t]); const float f = 1.f - kt; run *= f; c[t] = run; kk[t] = kt;
                    qs[t] = f;
                }
                DEC[pi * 128 + pk] = c[15];
                {
                    float sx[16]; float suf = 1.f;
#pragma unroll
                    for (int t = 15; t >= 0; --t) { sx[t] = suf; suf *= qs[t]; }
#pragma unroll
                    for (int t = 0; t < 16; t += 4) {
                        const s16x4 kd = pack4(kk[t] * sx[t], kk[t + 1] * sx[t + 1], kk[t + 2] * sx[t + 2], kk[t + 3] * sx[t + 3]);
                        *(LAS s16x4*)(KDT + pk * 136 + pi * 32 + t * 2) = kd; }
                }
                if (OUT) {
#pragma unroll
                    for (int t = 0; t < 16; t += 2) {
                        const float q0 = bf2f(qr[t]), q1 = bf2f(qr[t + 1]);
                        const unsigned qd2 = pk2(q0 * c[t], q1 * c[t + 1]);
                        const unsigned ki2 = pk2(kk[t] * __builtin_amdgcn_rcpf(fmaxf(c[t], 1e-35f)), kk[t + 1] * __builtin_amdgcn_rcpf(fmaxf(c[t + 1], 1e-35f)));
                        *(LAS bf16*)(QD + (16 * pi + t) * 272 + pk * 2) = (bf16)(qd2 & 0xffffu); *(LAS bf16*)(QD + (16 * pi + t + 1) * 272 + pk * 2) = (bf16)(qd2 >> 16);
                        *(LAS bf16*)(KINV + (16 * pi + t) * 272 + pk * 2) = (bf16)(ki2 & 0xffffu); *(LAS bf16*)(KINV + (16 * pi + t + 1) * 272 + pk * 2) = (bf16)(ki2 >> 16); }
                }
            }
            unsigned ogw[8];
            if (OUT) {
#pragma unroll
                for (int q8 = 0; q8 < 8; ++q8) ogw[q8] = *(const GAS unsigned*)(INP + (row0 + 8 * w + q8) * NIN + OFF_AG + h * 128 + 2 * F.lane);
            }
            __syncthreads();
            if (!OUT && F.tid < 128) decp *= (DEC[F.tid] * DEC[128 + F.tid]) * (DEC[256 + F.tid] * DEC[384 + F.tid]);
#pragma unroll 1
            for (int i = 0; i < 4; ++i) {
                const s16x4 vf = lds_tr16(VS + (16 * i + 4 * g4 + (li >> 2)) * 288 + (16 * w + 4 * (li & 3)) * 2);
                if (OUT) {
                    pg8::f32x4 ad = (pg8::f32x4){0.f, 0.f, 0.f, 0.f}; s16x4 qf[8];
#pragma unroll
                    for (int kb = 0; kb < 8; ++kb) { const s16x4 kf = *(const LAS s16x4*)(KINV + (16 * i + li) * 272 + (16 * kb + 4 * g4) * 2);
                        qf[kb] = *(const LAS s16x4*)(QD + (16 * i + li) * 272 + (16 * kb + 4 * g4) * 2);
                        ad = __builtin_amdgcn_mfma_f32_16x16x16bf16_1k(kf, qf[kb], ad, 0, 0, 0); }
#pragma unroll
                    for (int rg = 0; rg < 4; ++rg) if (4 * g4 + rg > li) ad[rg] = 0.f;
                    const s16x4 adf = pack4(ad[0], ad[1], ad[2], ad[3]);
                    pg8::f32x4 oT = __builtin_amdgcn_mfma_f32_16x16x16bf16_1k(vf, adf, (pg8::f32x4){0.f, 0.f, 0.f, 0.f}, 0, 0, 0);
#pragma unroll
                    for (int kb = 0; kb < 8; ++kb) { const s16x4 rf = pack4(R[kb][0], R[kb][1], R[kb][2], R[kb][3]);
                        oT = __builtin_amdgcn_mfma_f32_16x16x16bf16_1k(rf, qf[kb], oT, 0, 0, 0); }
                    *(LAS pg8::f32x4*)(OB + (16 * i + li) * 132 + 16 * w + 4 * g4) = oT;
                }
#pragma unroll
                for (int kb = 0; kb < 8; ++kb) { const pg8::f32x4 dv = *(const LAS pg8::f32x4*)(DEC + i * 128 + 16 * kb + 4 * g4);
                    const s16x4 kdf = *(const LAS s16x4*)(KDT + (16 * kb + li) * 136 + i * 32 + g4 * 8);
                    R[kb] = __builtin_amdgcn_mfma_f32_16x16x16bf16_1k(kdf, vf, R[kb] * dv, 0, 0, 0); }
            }
            if (OUT) {
                const float nw0 = NW[2 * F.lane], nw1 = NW[2 * F.lane + 1];
                __syncthreads();
#pragma unroll
                for (int q8 = 0; q8 < 8; ++q8) { const int t = 8 * w + q8; const size_t row = row0 + t;
                    const float o1 = OB[t * 132 + 2 * F.lane], o2 = OB[t * 132 + 2 * F.lane + 1];
                    const float r = __builtin_amdgcn_rsqf(wave_sum(o1 * o1 + o2 * o2) * (1.0f / 128.f) + EPS);
                    const float g1 = bflo(ogw[q8]), g2 = bfhi(ogw[q8]);
                    *(GAS unsigned*)(YC + row * DM + YC_A + h * 128 + 2 * F.lane) = pk2(o1 * r * nw0 * g1, o2 * r * nw1 * g2); }
            }
        }
        if (!OUT) {
            float* hs = HS + (size_t)it * 16384 + (size_t)(4 * g4) * 128 + 16 * w + li;
#pragma unroll
            for (int kb = 0; kb < 8; ++kb)
#pragma unroll
                for (int rg = 0; rg < 4; ++rg) hs[(16 * kb + rg) * 128] = R[kb][rg];
            if (F.tid < 128) HD[(size_t)it * 128 + F.tid] = decp;
        }
    }
}

constexpr int N_PHASES = 2 + 9 * DEPTH;
#define IN(p) (lo <= (p) && (p) < hi)
#define SEAM(p) do { if ((p) + 1 < hi) xcd_barrier(bar); } while (0)
template <int L> __device__ __forceinline__ void layer_phases(Frame& F, const Args& args, const int lo, const int hi, const XcdBarrier& bar) {
    constexpr int P0 = 2 + 9 * L;
    if (IN(P0 + 0)) {
        unsigned char* wl = F.ws + WS_W + (size_t)L * W_LAYER;
        const int NG = (L == 0 && F.G > G1_GEMM_CUS) ? G1_GEMM_CUS : F.G;
        if (F.bid < NG) {
            pg8::Gemm g{(const bf16*)(F.ws + WS_H), (const bf16*)(wl + WO_CAT1), DM, DM}; pg8::StaticOrder S; S.init(M, N1, DM, NG, F.bid);
            pg8::EpiInGate E{(bf16*)(F.ws + WS_INP), (bf16*)(F.ws + WS_GATES), args.in[IN_BGATE] + L * NGATE};
            pg8::gemm_phase<pg8::EpiInGate, pg8::StaticOrder>(F.lds + RING_OFF, g, S, E);
        } else if (L == 0) { if (GEMV_FIRST < GEMV_ALL) gemv_items(F, GEMV_FIRST, GEMV_ALL, F.bid - NG, F.G - NG); transposes(F, (F.bid - NG) * NWAVES + F.wave, (F.G - NG) * NWAVES, TR_FIRST, 2 * TR_PER_LAYER); }
        SEAM(P0 + 0);
    }
    if (IN(P0 + 1)) {
        hgrn_group_phase<false>(F, L, nullptr); __syncthreads(); attn_phase(F); __syncthreads(); conv_phase(F, L, (bf16*)(F.ws + WS_YCAT));
        SEAM(P0 + 1);
    }
    if (IN(P0 + 2)) {
        hgrn_group_phase<true>(F, L, (bf16*)(F.ws + WS_YCAT)); __syncthreads(); attn_combine_phase(F, (bf16*)(F.ws + WS_YCAT));
        SEAM(P0 + 2);
    }
    if (IN(P0 + 3)) {
        unsigned char* wl = F.ws + WS_W + (size_t)L * W_LAYER;
        pg8::Gemm g{(const bf16*)(F.ws + WS_YCAT), (const bf16*)(wl + WO_CAT2), DM, DM}; pg8::SegOrder3 S; S.init(M, DM, F.G, F.bid);
        pg8::EpiMerge E{(bf16*)(F.ws + WS_MERGED), (const bf16*)(F.ws + WS_GATES)};
        pg8::gemm_phase<pg8::EpiMerge, pg8::SegOrder3>(F.lds + RING_OFF, g, S, E);
        SEAM(P0 + 3);
    }
    if (IN(P0 + 4)) {
        unsigned char* wl = F.ws + WS_W + (size_t)L * W_LAYER;
        pg8::Gemm g{(const bf16*)(F.ws + WS_MERGED), (const bf16*)(wl + WO_O), DM, DM}; pg8::StaticOrder S; S.init(M, DM, DM, F.G, F.bid);
        pg8::EpiBf16 E{(bf16*)(F.ws + WS_Y), DM};
        pg8::gemm_phase<pg8::EpiBf16, pg8::StaticOrder>(F.lds + RING_OFF, g, S, E);
        SEAM(P0 + 4);
    }
    if (IN(P0 + 5)) {
        const float* modl = (const float*)(F.ws + WS_MOD) + (size_t)L * 4 * 12288;
        norm_phase(F, L == 0 ? args.in[IN_X] : args.out, args.out, (const bf16*)(F.ws + WS_Y), modl + 2 * 2048, args.in[IN_NPOST] + L * DM, args.in[IN_MPRE] + L * DM, modl + 4 * 2048, modl + 3 * 2048, (bf16*)(F.ws + WS_H));
        SEAM(P0 + 5);
    }
    if (IN(P0 + 6)) {
        unsigned char* wl = F.ws + WS_W + (size_t)L * W_LAYER;
        pg8::Gemm g{(const bf16*)(F.ws + WS_H), (const bf16*)(wl + WO_UP), DM, DM}; pg8::StaticOrder S; S.init(M, DFF, DM, F.G, F.bid);
        pg8::EpiRelu2 E{(bf16*)(F.ws + WS_U), DFF};
        pg8::gemm_phase<pg8::EpiRelu2, pg8::StaticOrder>(F.lds + RING_OFF, g, S, E);
        SEAM(P0 + 6);
    }
    if (IN(P0 + 7)) {
        unsigned char* wl = F.ws + WS_W + (size_t)L * W_LAYER;
        pg8::Gemm g{(const bf16*)(F.ws + WS_U), (const bf16*)(wl + WO_DOWN), DFF, DFF}; pg8::StaticOrder S; S.init(M, DM, DFF, F.G, F.bid);
        pg8::EpiBf16 E{(bf16*)(F.ws + WS_Y), DM};
        pg8::gemm_phase<pg8::EpiBf16, pg8::StaticOrder>(F.lds + RING_OFF, g, S, E);
        SEAM(P0 + 7);
    }
    if (IN(P0 + 8)) {
        const float* modl = (const float*)(F.ws + WS_MOD) + (size_t)L * 4 * 12288;
        const float* modn = (const float*)(F.ws + WS_MOD) + (size_t)(L + 1) * 4 * 12288;
        constexpr bool lastl = (L == DEPTH - 1);
        norm_phase(F, args.out, args.out, (const bf16*)(F.ws + WS_Y), modl + 5 * 2048, args.in[IN_MPOST] + L * DM, lastl ? nullptr : args.in[IN_NPRE] + (lastl ? 0 : (L + 1)) * DM, modn + 1 * 2048, modn + 0 * 2048, (bf16*)(F.ws + WS_H));
        SEAM(P0 + 8);
    }
}
__global__ void __launch_bounds__(NTHREADS, 2) mk_fwd(Args args) {
    extern __shared__ __attribute__((aligned(16))) unsigned char lds[];
    Frame F;
    F.lds = (LAS unsigned char*)lds; F.tid = threadIdx.x; F.lane = F.tid & 63; F.wave = __builtin_amdgcn_readfirstlane(F.tid >> 6);
    F.G = gridDim.x; F.bid = blockIdx.x; F.a = &args; F.ws = args.ws;
    volatile LAS unsigned* MISC = (volatile LAS unsigned*)(F.lds + MISC_OFF);
    if (F.tid < 32) MISC[F.tid] = 0u;
    __syncthreads();
    const int lo = args.ph_lo, hi = args.ph_hi;
    XcdBarrier bar; bar.bar = (unsigned*)(F.ws + WS_CTL) + 4096; bar.x = 0; bar.st = nullptr;
    if (hi - lo > 1) bar = xcd_barrier_post((unsigned*)(F.ws + WS_CTL) + 4096, MISC + 8);
    if (IN(0)) { prep_phase(F); SEAM(0); }
    if (IN(1)) { const float* MOD = (const float*)(F.ws + WS_MOD);
        norm_phase(F, args.in[IN_X], nullptr, nullptr, nullptr, nullptr, args.in[IN_NPRE], MOD + 1 * 2048, MOD + 0 * 2048, (bf16*)(F.ws + WS_H)); SEAM(1); }
    layer_phases<0>(F, args, lo, hi, bar);
    layer_phases<1>(F, args, lo, hi, bar);
}

extern "C" void kernel_launch(void* const* d_in, const int* in_sizes, int n_in, void* d_out, int out_size, void* d_ws, size_t ws_size, hipStream_t stream) {
    static int grid = 0;
    if (grid == 0) {
        if (n_in != 24 || out_size != M * DM || ws_size < WS_END) { fprintf(stderr, "kernel_launch: unexpected problem (n_in %d, out %d, ws %zu)\n", n_in, out_size, ws_size); grid = -1; return; }
        int dev = 0, cus = 0, per_cu = 0;
        if (hipGetDevice(&dev) != hipSuccess || hipDeviceGetAttribute(&cus, hipDeviceAttributeMultiprocessorCount, dev) != hipSuccess) { grid = -1; return; }
        if (hipFuncSetAttribute((const void*)mk_fwd, hipFuncAttributeMaxDynamicSharedMemorySize, LDS_BYTES) != hipSuccess) { fprintf(stderr, "kernel_launch: hipFuncSetAttribute failed\n"); grid = -1; return; }
        if (hipOccupancyMaxActiveBlocksPerMultiprocessor(&per_cu, (const void*)mk_fwd, NTHREADS, LDS_BYTES) != hipSuccess || per_cu < 1) { fprintf(stderr, "kernel_launch: occupancy query says %d blocks/CU\n", per_cu); grid = -1; (void)hipGetLastError(); return; }
        grid = cus;
    }
    if (grid < 0) return;
    (void)hipMemsetAsync((char*)d_ws + WS_CTL, 0, CTL_ZERO_BYTES, stream);
    Args a{};
    for (int i = 0; i < 24; ++i) a.in[i] = (const float*)d_in[i];
    a.out = (float*)d_out; a.ws = (unsigned char*)d_ws;
#if MK_ONE_LAUNCH
    a.ph_lo = 0; a.ph_hi = N_PHASES;
    void* kargs[] = {&a};
    hipError_t e = hipLaunchCooperativeKernel((const void*)mk_fwd, dim3(grid), dim3(NTHREADS), kargs, LDS_BYTES, stream);
    if (e != hipSuccess) fprintf(stderr, "kernel_launch: cooperative launch failed: %s\n", hipGetErrorString(e));
    if (PROBE_PHASE >= 0) { a.ph_lo = PROBE_PHASE; a.ph_hi = PROBE_PHASE + 1; hipLaunchKernelGGL(mk_fwd, dim3(grid), dim3(NTHREADS), LDS_BYTES, stream, a); }
#else
    for (int p = 0; p < N_PHASES; ++p) { a.ph_lo = p; a.ph_hi = p + 1; hipLaunchKernelGGL(mk_fwd, dim3(grid), dim3(NTHREADS), LDS_BYTES, stream, a); }
#endif
}
```

```cpp
#include <hip/hip_runtime.h>
#include <cstdio>
#include <cstdint>

#ifndef PROBE_PHASE
#define PROBE_PHASE -1
#endif
#ifndef MK_ONE_LAUNCH
#define MK_ONE_LAUNCH 1
#endif

namespace pg8 {
#define PG8_LAS __attribute__((address_space(3)))
typedef unsigned short bf16_t;
typedef short bf16x8 __attribute__((ext_vector_type(8)));
typedef float f32x4 __attribute__((ext_vector_type(4)));
typedef unsigned u32x4 __attribute__((ext_vector_type(4)));
constexpr int BM = 256, BK = 64, HALF = 128, HTB = HALF * BK * 2, STAGE_BYTES = 8 * HTB, NXCD = 8, WGM = 8;

__host__ __device__ __forceinline__ int lds_byte(int r, int c) { const int st = (r >> 4) * 2 + (c >> 5), rr = r & 15, cc = c & 31, ob = rr * 64 + cc * 2; return st * 1024 + (ob ^ (((ob >> 9) & 1) << 5)); }
__host__ __device__ __forceinline__ void stage_rc(int b, int& R, int& C) { const int st = b / 1024, sb = b % 1024, swz = sb ^ (((sb >> 9) & 1) << 5); R = (st >> 1) * 16 + swz / 64; C = (st & 1) * 32 + (swz % 64) / 2; }
__host__ __device__ __forceinline__ int perm32(int rho) { const int n = rho >> 4, i = rho & 15; return 8 * (i >> 2) + 4 * n + (i & 3); }

struct Unit { int pm, pn, koff, nt, seg; };
struct Gemm { const bf16_t* A; const bf16_t* Bt; int lda, ldb; };

__device__ __forceinline__ void tile_of(int L, int nM, int nN, int& pm, int& pn) {
    const int nwg = nM * nN; int wgid = L;
    { const int q = nwg / NXCD, r = nwg % NXCD, xcd = wgid % NXCD, off = wgid / NXCD; wgid = (xcd < r ? xcd * (q + 1) : r * (q + 1) + (xcd - r) * q) + off; }
    const int nig = WGM * nN, gid = wgid / nig, fm = gid * WGM, gsz = (nM - fm) < WGM ? (nM - fm) : WGM;
    pm = fm + ((wgid % nig) % gsz); pn = (wgid % nig) / gsz;
}
struct StaticOrder {
    int nM, nN, nwg, G, c, nt;
    __device__ void init(int M, int N, int K, int G_, int c_) { nM = M / BM; nN = N / BM; nwg = nM * nN; G = G_; c = c_; nt = K / BK; }
    __device__ bool next(int i, Unit& u) const {
        const long L = (long)i * G + c; if (L >= nwg) return false;
        tile_of((int)L, nM, nN, u.pm, u.pn); u.koff = 0; u.nt = nt; u.seg = 0; return true;
    }
};
struct SegOrder3 {
    int nM, nN, nwg, G, c;
    __device__ void init(int M, int N, int G_, int c_) { nM = M / BM; nN = N / BM; nwg = nM * nN; G = G_; c = c_; }
    __device__ bool next(int i, Unit& u) const {
        const int ti = i / 3, seg = i - ti * 3; const long L = (long)ti * G + c; if (L >= nwg) return false;
        tile_of((int)L, nM, nN, u.pm, u.pn); u.seg = seg;
        u.koff = seg == 0 ? 0 : (seg == 1 ? 1024 : 1280); u.nt = seg == 0 ? 16 : (seg == 1 ? 4 : 12); return true;
    }
};

typedef __bf16 bf16x2_t __attribute__((ext_vector_type(2)));
__device__ __forceinline__ unsigned cvt_pk_bf16(float lo, float hi) { bf16x2_t v; v[0] = (__bf16)lo; v[1] = (__bf16)hi; return __builtin_bit_cast(unsigned, v); }
__device__ __forceinline__ float bf_lo(unsigned w) { return __uint_as_float(w << 16); }
__device__ __forceinline__ float bf_hi(unsigned w) { return __uint_as_float(w & 0xffff0000u); }
__device__ __forceinline__ float sigmoidf_fast(float x) { return __builtin_amdgcn_rcpf(1.0f + __expf(-x)); }

struct EpiF32 {
    static constexpr bool PERM = false, KEEP_ACC = false, AFTER_DRAIN = false;
    float* C; int ldc;
    __device__ __forceinline__ void operator()(const f32x4 (&acc)[2][2][4][2], const Unit& u, int wr, int wc, int fr, int fq) const {
        const int row0 = u.pm * BM + wr * 64 + fr, col0 = u.pn * BM + wc * 32 + 4 * fq;
#pragma unroll
        for (int ai = 0; ai < 2; ++ai)
#pragma unroll
            for (int m = 0; m < 4; ++m) { float* rowp = C + (size_t)(row0 + ai * HALF + m * 16) * ldc + col0;
#pragma unroll
                for (int bj = 0; bj < 2; ++bj)
#pragma unroll
                    for (int n = 0; n < 2; ++n) *(f32x4*)(rowp + bj * HALF + n * 16) = acc[ai][bj][m][n]; }
    }
};
struct EpiBf16 {
    static constexpr bool PERM = true, KEEP_ACC = false, AFTER_DRAIN = false;
    bf16_t* O; int ldc;
    __device__ __forceinline__ void operator()(const f32x4 (&acc)[2][2][4][2], const Unit& u, int wr, int wc, int fr, int fq) const {
        const int row0 = u.pm * BM + wr * 64 + fr, col0 = u.pn * BM + wc * 32 + 8 * fq;
#pragma unroll
        for (int ai = 0; ai < 2; ++ai)
#pragma unroll
            for (int m = 0; m < 4; ++m) { bf16_t* rowp = O + (size_t)(row0 + ai * HALF + m * 16) * ldc + col0;
#pragma unroll
                for (int bj = 0; bj < 2; ++bj) { const f32x4 v0 = acc[ai][bj][m][0], v1 = acc[ai][bj][m][1];
                    u32x4 w; w.x = cvt_pk_bf16(v0[0], v0[1]); w.y = cvt_pk_bf16(v0[2], v0[3]); w.z = cvt_pk_bf16(v1[0], v1[1]); w.w = cvt_pk_bf16(v1[2], v1[3]);
                    *(u32x4*)(rowp + bj * HALF) = w; } }
    }
};
struct EpiInGate {
    static constexpr bool PERM = true, KEEP_ACC = false, AFTER_DRAIN = false;
    bf16_t* INP; bf16_t* GATES; const float* bgate;
    __device__ __forceinline__ void operator()(const f32x4 (&acc)[2][2][4][2], const Unit& u, int wr, int wc, int fr, int fq) const {
        const int row0 = u.pm * BM + wr * 64 + fr; const bool gate = u.pn >= 31;
        const int colt = (gate ? (u.pn - 31) : u.pn) * BM, ldc = gate ? 6144 : 7936; bf16_t* base = gate ? GATES : INP;
        const int col0 = colt + wc * 32 + 8 * fq;
        f32x4 bv[2][2];
#pragma unroll
        for (int bj = 0; bj < 2; ++bj)
#pragma unroll
            for (int n = 0; n < 2; ++n) bv[bj][n] = gate ? *(const f32x4*)(bgate + col0 + bj * HALF + 4 * n) : (f32x4){0.f, 0.f, 0.f, 0.f};
        if (u.pn >= 25 && u.pn < 31) {
            bf16_t* ub = INP + (size_t)row0 * 7936 + 6400 + (u.pn - 25) * 128 + wc * 32 + 8 * fq;
#pragma unroll
            for (int ai = 0; ai < 2; ++ai)
#pragma unroll
                for (int m = 0; m < 4; ++m) { f32x4 v0 = acc[ai][0][m][0], v1 = acc[ai][0][m][1]; const f32x4 g0 = acc[ai][1][m][0], g1 = acc[ai][1][m][1];
#pragma unroll
                    for (int j = 0; j < 4; ++j) { v0[j] *= sigmoidf_fast(g0[j]); v1[j] *= sigmoidf_fast(g1[j]); }
                    u32x4 w; w.x = cvt_pk_bf16(v0[0], v0[1]); w.y = cvt_pk_bf16(v0[2], v0[3]); w.z = cvt_pk_bf16(v1[0], v1[1]); w.w = cvt_pk_bf16(v1[2], v1[3]);
                    *(u32x4*)(ub + (size_t)(ai * HALF + m * 16) * 7936) = w; }
            return;
        }
        const int hact = (u.pn < 4 || (u.pn >= 12 && u.pn < 16)) ? 1 : ((u.pn >= 4 && u.pn < 8) ? 2 : 0);
#pragma unroll
        for (int ai = 0; ai < 2; ++ai)
#pragma unroll
            for (int m = 0; m < 4; ++m) { bf16_t* rowp = base + (size_t)(row0 + ai * HALF + m * 16) * ldc + col0;
#pragma unroll
                for (int bj = 0; bj < 2; ++bj) { f32x4 v0 = acc[ai][bj][m][0] + bv[bj][0], v1 = acc[ai][bj][m][1] + bv[bj][1];
                    if (hact == 1) {
#pragma unroll
                        for (int j = 0; j < 4; ++j) { v0[j] *= sigmoidf_fast(v0[j]); v1[j] *= sigmoidf_fast(v1[j]); } }
                    if (hact == 2) {
#pragma unroll
                        for (int j = 0; j < 4; ++j) { v0[j] = sigmoidf_fast(-v0[j]); v1[j] = sigmoidf_fast(-v1[j]); } }
                    if (gate) {
#pragma unroll
                        for (int j = 0; j < 4; ++j) { v0[j] = fmaxf(sigmoidf_fast(v0[j]), 1e-20f); v1[j] = fmaxf(sigmoidf_fast(v1[j]), 1e-20f); } }
                    u32x4 w; w.x = cvt_pk_bf16(v0[0], v0[1]); w.y = cvt_pk_bf16(v0[2], v0[3]); w.z = cvt_pk_bf16(v1[0], v1[1]); w.w = cvt_pk_bf16(v1[2], v1[3]);
                    *(u32x4*)(rowp + bj * HALF) = w; } }
    }
};
struct EpiRelu2 {
    static constexpr bool PERM = true, KEEP_ACC = false, AFTER_DRAIN = false;
    bf16_t* O; int ldc;
    __device__ __forceinline__ void operator()(const f32x4 (&acc)[2][2][4][2], const Unit& u, int wr, int wc, int fr, int fq) const {
        const int row0 = u.pm * BM + wr * 64 + fr, col0 = u.pn * BM + wc * 32 + 8 * fq;
#pragma unroll
        for (int ai = 0; ai < 2; ++ai)
#pragma unroll
            for (int m = 0; m < 4; ++m) { bf16_t* rowp = O + (size_t)(row0 + ai * HALF + m * 16) * ldc + col0;
#pragma unroll
                for (int bj = 0; bj < 2; ++bj) { f32x4 v0 = acc[ai][bj][m][0], v1 = acc[ai][bj][m][1];
#pragma unroll
                    for (int j = 0; j < 4; ++j) { const float a = fmaxf(v0[j], 0.f), b = fmaxf(v1[j], 0.f); v0[j] = a * a; v1[j] = b * b; }
                    u32x4 w; w.x = cvt_pk_bf16(v0[0], v0[1]); w.y = cvt_pk_bf16(v0[2], v0[3]); w.z = cvt_pk_bf16(v1[0], v1[1]); w.w = cvt_pk_bf16(v1[2], v1[3]);
                    *(u32x4*)(rowp + bj * HALF) = w; } }
    }
};
struct EpiMerge {
    static constexpr bool PERM = true, KEEP_ACC = true, AFTER_DRAIN = false;
    bf16_t* MERGED; const bf16_t* GATES;
    __device__ __forceinline__ void operator()(f32x4 (&acc)[2][2][4][2], const Unit& u, int wr, int wc, int fr, int fq) const {
        const int row0 = u.pm * BM + wr * 64 + fr, col0 = u.pn * BM + wc * 32 + 8 * fq; const int seg = u.seg;
#pragma unroll
        for (int ai = 0; ai < 2; ++ai)
#pragma unroll
            for (int m = 0; m < 4; ++m) { const size_t row = (size_t)(row0 + ai * HALF + m * 16);
#pragma unroll
                for (int bj = 0; bj < 2; ++bj) {
                    const bf16_t* gp = GATES + row * 6144 + col0 + bj * HALF;
                    f32x4& a0 = acc[ai][bj][m][0]; f32x4& a1 = acc[ai][bj][m][1];
                    if (seg != 2) {
                        const u32x4 gn = *(const u32x4*)(gp + seg * 2048), gd = *(const u32x4*)(gp + (seg + 1) * 2048);
                        a0[0] *= bf_lo(gn.x) * __builtin_amdgcn_rcpf(bf_lo(gd.x)); a0[1] *= bf_hi(gn.x) * __builtin_amdgcn_rcpf(bf_hi(gd.x));
                        a0[2] *= bf_lo(gn.y) * __builtin_amdgcn_rcpf(bf_lo(gd.y)); a0[3] *= bf_hi(gn.y) * __builtin_amdgcn_rcpf(bf_hi(gd.y));
                        a1[0] *= bf_lo(gn.z) * __builtin_amdgcn_rcpf(bf_lo(gd.z)); a1[1] *= bf_hi(gn.z) * __builtin_amdgcn_rcpf(bf_hi(gd.z));
                        a1[2] *= bf_lo(gn.w) * __builtin_amdgcn_rcpf(bf_lo(gd.w)); a1[3] *= bf_hi(gn.w) * __builtin_amdgcn_rcpf(bf_hi(gd.w));
                    } else {
                        const u32x4 g = *(const u32x4*)(gp + 2 * 2048);
                        u32x4 w; w.x = cvt_pk_bf16(a0[0] * bf_lo(g.x), a0[1] * bf_hi(g.x)); w.y = cvt_pk_bf16(a0[2] * bf_lo(g.y), a0[3] * bf_hi(g.y));
                        w.z = cvt_pk_bf16(a1[0] * bf_lo(g.z), a1[1] * bf_hi(g.z)); w.w = cvt_pk_bf16(a1[2] * bf_lo(g.w), a1[3] * bf_hi(g.w));
                        *(u32x4*)(MERGED + row * 2048 + col0 + bj * HALF) = w; } } }
    }
};

struct EpiNormFused {
    static constexpr bool PERM = false, KEEP_ACC = false, AFTER_DRAIN = true;
    const float* xin; float* xout; bf16_t* H;
    const float* g; const float* wpost; const float* wpre; const float* sc; const float* sh;
    float* xs1; float* xs2; unsigned* cnt1; unsigned* cnt2;
    __device__ __forceinline__ void operator()(const f32x4 (&)[2][2][4][2], const Unit&, int, int, int, int) const {}
    __device__ __forceinline__ void row_rstd(const f32x4 (&v)[2][2][4][2], const Unit& u, int wr, int wc, int fr, int fq, PG8_LAS float* P, PG8_LAS float* S, float* xs, unsigned* cnt, int tid) const {
#pragma unroll
        for (int ai = 0; ai < 2; ++ai)
#pragma unroll
            for (int m = 0; m < 4; ++m) { float s = 0.f;
#pragma unroll
                for (int bj = 0; bj < 2; ++bj)
#pragma unroll
                    for (int n = 0; n < 2; ++n) { const f32x4 x = v[ai][bj][m][n]; s += (x[0] * x[0] + x[1] * x[1]) + (x[2] * x[2] + x[3] * x[3]); }
                s += __shfl_xor(s, 16); s += __shfl_xor(s, 32);
                if (fq == 0) P[(ai * HALF + wr * 64 + m * 16 + fr) * 4 + wc] = s; }
        __syncthreads();
        if (tid < 256) { const float t = (P[tid * 4] + P[tid * 4 + 1]) + (P[tid * 4 + 2] + P[tid * 4 + 3]);
            __hip_atomic_store(xs + (size_t)(u.pm * BM + tid) * 8 + u.pn, t, __ATOMIC_RELAXED, __HIP_MEMORY_SCOPE_AGENT); }
        asm volatile("s_waitcnt vmcnt(0)" ::: "memory");
        __syncthreads();
        if (tid == 0) { __hip_atomic_fetch_add(cnt + 64 * u.pm, 1u, __ATOMIC_RELAXED, __HIP_MEMORY_SCOPE_AGENT);
            unsigned sp = 0;
            while (__hip_atomic_load(cnt + 64 * u.pm, __ATOMIC_RELAXED, __HIP_MEMORY_SCOPE_AGENT) < 8u) { __builtin_amdgcn_s_sleep(1); if (++sp > (1u << 22)) break; } }
        __syncthreads();
        if (tid < 256) { const float* q = xs + (size_t)(u.pm * BM + tid) * 8; float t = 0.f;
#pragma unroll
            for (int j = 0; j < 8; ++j) t += __hip_atomic_load(q + j, __ATOMIC_RELAXED, __HIP_MEMORY_SCOPE_AGENT);
            S[tid] = __builtin_amdgcn_rsqf(t * (1.0f / 2048.f) + 1e-6f); }
        __syncthreads();
    }
    __device__ __forceinline__ void fused(f32x4 (&acc)[2][2][4][2], const Unit& u, int wr, int wc, int fr, int fq, PG8_LAS unsigned char* lds, int tid) const {
        PG8_LAS float* P = (PG8_LAS float*)lds; PG8_LAS float* S = (PG8_LAS float*)(lds + 4096);
        const int b = u.pm >> 3, col0 = u.pn * BM + wc * 32 + 4 * fq, row0 = u.pm * BM + wr * 64 + fr;
        row_rstd(acc, u, wr, wc, fr, fq, P, S, xs1, cnt1, tid);
        {
            f32x4 gw[2][2];
#pragma unroll
            for (int bj = 0; bj < 2; ++bj)
#pragma unroll
                for (int n = 0; n < 2; ++n) gw[bj][n] = *(const f32x4*)(g + (size_t)b * 12288 + col0 + bj * HALF + n * 16) * *(const f32x4*)(wpost + col0 + bj * HALF + n * 16);
#pragma unroll
            for (int ai = 0; ai < 2; ++ai)
#pragma unroll
                for (int m = 0; m < 4; ++m) { const int r = ai * HALF + wr * 64 + m * 16 + fr; const float rs = S[r]; const size_t off = (size_t)(u.pm * BM + r) * 2048 + col0;
                    f32x4 xv[2][2];
#pragma unroll
                    for (int bj = 0; bj < 2; ++bj)
#pragma unroll
                        for (int n = 0; n < 2; ++n) xv[bj][n] = *(const f32x4*)(xin + off + bj * HALF + n * 16);
#pragma unroll
                    for (int bj = 0; bj < 2; ++bj)
#pragma unroll
                        for (int n = 0; n < 2; ++n) { const f32x4 xn = xv[bj][n] + gw[bj][n] * (acc[ai][bj][m][n] * rs); acc[ai][bj][m][n] = xn; *(f32x4*)(xout + off + bj * HALF + n * 16) = xn; }
                    asm volatile("" ::: "memory"); }
        }
        if (wpre == nullptr) return;
        row_rstd(acc, u, wr, wc, fr, fq, P, S, xs2, cnt2, tid);
        {
            f32x4 a[2][2], c[2][2];
#pragma unroll
            for (int bj = 0; bj < 2; ++bj)
#pragma unroll
                for (int n = 0; n < 2; ++n) { const int cc = col0 + bj * HALF + n * 16;
                    a[bj][n] = *(const f32x4*)(wpre + cc) * (*(const f32x4*)(sc + (size_t)b * 12288 + cc) + 1.0f); c[bj][n] = *(const f32x4*)(sh + (size_t)b * 12288 + cc); }
#pragma unroll
            for (int ai = 0; ai < 2; ++ai)
#pragma unroll
                for (int m = 0; m < 4; ++m) { const int r = ai * HALF + wr * 64 + m * 16 + fr; const float rs = S[r]; bf16_t* hp = H + (size_t)(u.pm * BM + r) * 2048 + col0;
#pragma unroll
                    for (int bj = 0; bj < 2; ++bj)
#pragma unroll
                        for (int n = 0; n < 2; ++n) { const f32x4 h = (acc[ai][bj][m][n] * rs) * a[bj][n] + c[bj][n];
                            unsigned long long w = (unsigned long long)cvt_pk_bf16(h[0], h[1]) | ((unsigned long long)cvt_pk_bf16(h[2], h[3]) << 32);
                            *(unsigned long long*)(hp + bj * HALF + n * 16) = w; } }
        }
    }
};

template <class Epi, class Sched, bool ALIGN_EPI = true>
__device__ __forceinline__ void gemm_phase(PG8_LAS unsigned char* lds, const Gemm g, const Sched& S, const Epi& E) {
    const int tid = threadIdx.x, wid = __builtin_amdgcn_readfirstlane(tid >> 6), lane = tid & 63, wr = wid >> 2, wc = wid & 3, fr = lane & 15, fq = lane >> 4;
    unsigned voffA[2], voffB[2];
#pragma unroll
    for (int i = 0; i < 2; ++i) { int R, C; stage_rc(tid * 16 + i * 8192, R, C); const int Rb = Epi::PERM ? ((R & ~31) + perm32(R & 31)) : R;
        voffA[i] = (unsigned)(R * g.lda + C) * 2u; voffB[i] = (unsigned)(Rb * g.ldb + C) * 2u; }
    const size_t kstep = (size_t)(BK * 2);
    const size_t hstepA = (size_t)HALF * g.lda * 2, hstepB = (size_t)HALF * g.ldb * 2;
    const size_t tstepA = 2 * hstepA, tstepB = 2 * hstepB;
    const unsigned ldsw = (unsigned)wid * 1024u;
    const int aoff = lds_byte(wr * 64 + fr, fq * 8), boff = lds_byte(wc * 32 + fr, fq * 8);
#define PG8_SA(b, h) (((b) * 2 + (h)) * HTB)
#define PG8_SB(b, h) ((4 + (b) * 2 + (h)) * HTB)
#define PG8_STAGE(bufoff, gbase, voff) do { _Pragma("unroll") for (int _i = 0; _i < 2; ++_i) \
        __builtin_amdgcn_global_load_lds((const unsigned*)((const char*)(gbase) + (voff)[_i]), (PG8_LAS unsigned*)(lds + (bufoff) + ldsw + _i * 8192), 16, 0, 0); } while (0)
#define PG8_LDA(dst, b, h) do { _Pragma("unroll") for (int m = 0; m < 4; ++m) _Pragma("unroll") for (int k = 0; k < 2; ++k) dst[m][k] = *(const PG8_LAS bf16x8*)(lds + PG8_SA(b, h) + aoff + m * 2048 + k * 1024); } while (0)
#define PG8_LDB(dst, b, h) do { _Pragma("unroll") for (int n = 0; n < 2; ++n) _Pragma("unroll") for (int k = 0; k < 2; ++k) dst[n][k] = *(const PG8_LAS bf16x8*)(lds + PG8_SB(b, h) + boff + n * 2048 + k * 1024); } while (0)
#define PG8_MMA(ai, bj, At, Bt) do { __builtin_amdgcn_s_setprio(1); _Pragma("unroll") for (int m = 0; m < 4; ++m) _Pragma("unroll") for (int n = 0; n < 2; ++n) _Pragma("unroll") for (int k = 0; k < 2; ++k) \
        acc[ai][bj][m][n] = __builtin_amdgcn_mfma_f32_16x16x32_bf16(Bt[n][k], At[m][k], acc[ai][bj][m][n], 0, 0, 0); __builtin_amdgcn_s_setprio(0); } while (0)
#define PG8_WAIT_V(n) asm volatile("s_waitcnt vmcnt(" #n ")" ::: "memory")
#define PG8_WAIT_L(n) asm volatile("s_waitcnt lgkmcnt(" #n ")" ::: "memory")
#define PG8_BAR __builtin_amdgcn_s_barrier()
#define PG8_SCHED __builtin_amdgcn_sched_barrier(0)
    Unit cur, nxt; int ui = 0;
    if (!S.next(0, cur)) return;
    f32x4 acc[2][2][4][2];
#pragma unroll
    for (int a = 0; a < 2; ++a)
#pragma unroll
        for (int b = 0; b < 2; ++b)
#pragma unroll
            for (int m = 0; m < 4; ++m)
#pragma unroll
                for (int n = 0; n < 2; ++n) acc[a][b][m][n] = (f32x4){0.f, 0.f, 0.f, 0.f};
    bf16x8 At[4][2], B0[2][2], B1[2][2];
    const char* cA = (const char*)g.A + (size_t)cur.pm * tstepA + (size_t)cur.koff * 2; const char* cB = (const char*)g.Bt + (size_t)cur.pn * tstepB + (size_t)cur.koff * 2;
    PG8_STAGE(PG8_SB(0, 0), cB, voffB); PG8_STAGE(PG8_SB(0, 1), cB + hstepB, voffB); PG8_STAGE(PG8_SA(0, 0), cA, voffA); PG8_STAGE(PG8_SA(0, 1), cA + hstepA, voffA);
    if (wr == 1) PG8_BAR;
    PG8_WAIT_V(2); PG8_BAR;
    PG8_STAGE(PG8_SB(1, 0), cB + kstep, voffB); PG8_STAGE(PG8_SA(1, 0), cA + kstep, voffA); PG8_STAGE(PG8_SB(1, 1), cB + hstepB + kstep, voffB);
    PG8_WAIT_V(6); PG8_BAR;
    for (;;) {
        const bool has_next = S.next(ui + 1, nxt);
        const char* nA = has_next ? (const char*)g.A + (size_t)nxt.pm * tstepA + (size_t)nxt.koff * 2 : cA;
        const char* nB = has_next ? (const char*)g.Bt + (size_t)nxt.pn * tstepB + (size_t)nxt.koff * 2 : cB;
        const int nt = cur.nt;
        for (int t = 0; t < nt; t += 2) {
            const bool last = (t == nt - 2);
            const char* a1 = cA + (size_t)(t + 1) * kstep;
            const char* a2 = last ? nA : cA + (size_t)(t + 2) * kstep; const char* b2 = last ? nB : cB + (size_t)(t + 2) * kstep;
            const char* a3 = a2 + kstep; const char* b3 = b2 + kstep;
            PG8_LDB(B0, 0, 0); PG8_LDB(B1, 0, 1); PG8_SCHED; PG8_LDA(At, 0, 0); PG8_STAGE(PG8_SA(1, 1), a1 + hstepA, voffA);
            PG8_WAIT_V(8); PG8_WAIT_L(0); PG8_BAR; PG8_MMA(0, 0, At, B0); PG8_MMA(0, 1, At, B1); PG8_BAR; PG8_SCHED;
            PG8_LDA(At, 0, 1); PG8_STAGE(PG8_SB(0, 0), b2, voffB); PG8_STAGE(PG8_SB(0, 1), b2 + hstepB, voffB); PG8_STAGE(PG8_SA(0, 0), a2, voffA);
            PG8_WAIT_V(8); PG8_WAIT_L(0); PG8_BAR; PG8_MMA(1, 0, At, B0); PG8_MMA(1, 1, At, B1); PG8_BAR; PG8_SCHED;
            PG8_LDB(B0, 1, 0); PG8_LDB(B1, 1, 1); PG8_SCHED; PG8_LDA(At, 1, 0); PG8_STAGE(PG8_SA(0, 1), a2 + hstepA, voffA);
            PG8_WAIT_V(8); PG8_WAIT_L(0); PG8_BAR; PG8_MMA(0, 0, At, B0); PG8_MMA(0, 1, At, B1); PG8_BAR; PG8_SCHED;
            PG8_LDA(At, 1, 1); PG8_STAGE(PG8_SB(1, 0), b3, voffB); PG8_STAGE(PG8_SB(1, 1), b3 + hstepB, voffB); PG8_STAGE(PG8_SA(1, 0), a3, voffA);
            PG8_WAIT_V(8); PG8_WAIT_L(0); PG8_BAR; PG8_MMA(1, 0, At, B0); PG8_MMA(1, 1, At, B1); PG8_BAR; PG8_SCHED;
        }
        if constexpr (ALIGN_EPI) { if (wr == 0) PG8_BAR; }
        if constexpr (!Epi::AFTER_DRAIN) E(acc, cur, wr, wc, fr, fq);
        if (!has_next) break;
        if (!(Epi::KEEP_ACC && nxt.seg != 0)) {
#pragma unroll
        for (int a = 0; a < 2; ++a)
#pragma unroll
            for (int b = 0; b < 2; ++b)
#pragma unroll
                for (int m = 0; m < 4; ++m)
#pragma unroll
                    for (int n = 0; n < 2; ++n) acc[a][b][m][n] = (f32x4){0.f, 0.f, 0.f, 0.f};
        }
        cur = nxt; cA = nA; cB = nB; ++ui;
        if constexpr (ALIGN_EPI) { if (wr == 1) PG8_BAR; }
    }
    PG8_WAIT_V(0);
    if constexpr (!ALIGN_EPI) { if (wr == 0) PG8_BAR; }
    PG8_BAR;
    if constexpr (Epi::AFTER_DRAIN) E.fused(acc, cur, wr, wc, fr, fq, lds, tid);
#undef PG8_SA
#undef PG8_SB
#undef PG8_STAGE
#undef PG8_LDA
#undef PG8_LDB
#undef PG8_MMA
#undef PG8_WAIT_V
#undef PG8_WAIT_L
#undef PG8_BAR
#undef PG8_SCHED
}
}

constexpr int NWAVES = 8, NTHREADS = 512;
constexpr int DM = 2048, NB = 4, SEQ = 2048, M = NB * SEQ, DEPTH = 2, DFF = 8192;
constexpr int NIN = 7936, NGATE = 6144, N1 = NIN + NGATE;
constexpr int OFF_AQ = 0, OFF_AF = 1024, OFF_AI = 2048, OFF_AG = 3072, OFF_BQ = 4096, OFF_BK = 4864, OFF_BV = 5632, OFF_CA = 6400, OFF_CG = 7168;
constexpr int YC_A = 0, YC_B = 1024, YC_C = 1280;
constexpr float EPS = 1e-6f;

constexpr size_t MiB = 1u << 20;
constexpr size_t WS_CTL = 0, CTL_ZERO_BYTES = 128 * 1024;
constexpr size_t WS_MOD = 1 * MiB;
constexpr size_t WS_LB = WS_MOD + 512 * 1024;
constexpr size_t WS_BIAS = WS_LB + 16 * 1024;
constexpr size_t WS_W = 2 * MiB, W_LAYER = 135 * MiB;
constexpr size_t WO_CAT1 = 0, WO_CAT2 = 55 * MiB, WO_O = 63 * MiB, WO_UP = 71 * MiB, WO_DOWN = 103 * MiB;
constexpr size_t WS_H = 272 * MiB;
constexpr size_t WS_INP = 304 * MiB;
constexpr size_t WS_GATES = 428 * MiB;
constexpr size_t WS_U = WS_INP;
constexpr size_t WS_YCAT = 524 * MiB;
constexpr size_t WS_MPART = 556 * MiB;
constexpr size_t WS_Y = WS_MPART;
constexpr size_t WS_MERGED = 620 * MiB;
constexpr size_t WS_ATTO = 652 * MiB;
constexpr size_t WS_ATTL = 676 * MiB;
constexpr size_t WS_HDEC = 676 * MiB + 512 * 1024;
constexpr size_t WS_HSTATE = WS_MPART;
constexpr size_t WS_XS = 677 * MiB;
constexpr size_t WS_CNT = 32 * 1024;
constexpr int GEMV_CNT_WORD = 8 * 2048;
constexpr size_t WS_END = 680 * MiB;

constexpr int G1_GEMM_CUS = 220;
constexpr int LDS_BYTES = 147456;
constexpr int RING_OFF = 0, MISC_OFF = LDS_BYTES - 256;

#define GAS __attribute__((address_space(1)))
#define LAS __attribute__((address_space(3)))
typedef unsigned short bf16;
typedef unsigned v4u __attribute__((ext_vector_type(4)));
typedef unsigned v2u __attribute__((ext_vector_type(2)));
typedef float f32x4 __attribute__((ext_vector_type(4)));
typedef float f32x2 __attribute__((ext_vector_type(2)));
typedef GAS unsigned gu32;
#define RLX_AGENT __ATOMIC_RELAXED, __HIP_MEMORY_SCOPE_AGENT
#define LDS_WAIT() asm volatile("s_waitcnt lgkmcnt(0)" ::: "memory")
__device__ __forceinline__ unsigned f2bf(float f) { unsigned u = __builtin_bit_cast(unsigned, f); return (u + 0x7fffu + ((u >> 16) & 1u)) >> 16; }
typedef __bf16 bf16x2_t __attribute__((ext_vector_type(2)));
__device__ __forceinline__ unsigned pk2(float lo, float hi) { bf16x2_t v; v[0] = (__bf16)lo; v[1] = (__bf16)hi; return __builtin_bit_cast(unsigned, v); }
__device__ __forceinline__ float bf2f(bf16 b) { return __uint_as_float(((unsigned)b) << 16); }
__device__ __forceinline__ float bflo(unsigned w) { return __uint_as_float(w << 16); }
__device__ __forceinline__ float bfhi(unsigned w) { return __uint_as_float(w & 0xffff0000u); }
__device__ __forceinline__ float sigm(float x) { return __builtin_amdgcn_rcpf(1.0f + __expf(-x)); }

#define XB_TMO      128
#define XB_XCNT(j)  (256  + 64 * (j))
#define XB_XSUB(j)  (1280 + 64 * (j))
#define XB_XGEN(j)  (2304 + 64 * (j))
#define XB_TOP      3328
#define XB_TOPGEN   3392
#define XCD_BAR_WORDS 3456
#define XB_SPIN_CAP (1u << 22)
__device__ __forceinline__ unsigned xb_ld(unsigned* p)              { return __hip_atomic_load(p, __ATOMIC_RELAXED, __HIP_MEMORY_SCOPE_AGENT); }
__device__ __forceinline__ unsigned xb_add(unsigned* p, unsigned v) { return __hip_atomic_fetch_add(p, v, __ATOMIC_RELAXED, __HIP_MEMORY_SCOPE_AGENT); }
__device__ __forceinline__ unsigned xb_xcc_id() { return (unsigned)__builtin_amdgcn_s_getreg((3 << 11) | 20) & 0xFu; }
#define XB_SPIN(cond, bar) do { unsigned _sp = 0; while (cond) { __builtin_amdgcn_s_sleep(1); \
    if ((++_sp & 255u) == 0u) { if (xb_ld(&(bar)[XB_TMO])) break; if (_sp > XB_SPIN_CAP) { atomicAdd(&(bar)[XB_TMO], 1u); break; } } } } while (0)
struct XcdBarrier { unsigned* bar; unsigned x; volatile LAS unsigned* st; };
__device__ __forceinline__ XcdBarrier xcd_barrier_post(unsigned* bar, volatile LAS unsigned* st) {
    XcdBarrier b; b.bar = bar; b.x = xb_xcc_id(); b.st = st;
    if (threadIdx.x == 0) (void)xb_add(&bar[XB_XCNT(b.x)], 1u);
    return b;
}
__device__ __forceinline__ void xcd_barrier_complete(unsigned* bar, unsigned x, unsigned& nloc, unsigned& nx) {
    const unsigned G = gridDim.x * gridDim.y * gridDim.z;
    unsigned sum, cnt, mine, sp = 0u;
    for (;;) {
        sum = 0u; cnt = 0u; mine = 0u;
#pragma unroll
        for (unsigned j = 0; j < 16; ++j) { const unsigned c = xb_ld(&bar[XB_XCNT(j)]); sum += c; cnt += (c > 0u) ? 1u : 0u; mine = (j == x) ? c : mine; }
        if (sum == G) break;
        __builtin_amdgcn_s_sleep(1);
        if ((++sp & 255u) == 0u) { if (xb_ld(&bar[XB_TMO])) break; if (sp > XB_SPIN_CAP) { atomicAdd(&bar[XB_TMO], 1u); break; } }
    }
    nloc = mine > 0u ? mine : 1u; nx = cnt > 0u ? cnt : 1u;
}
__device__ __forceinline__ void xcd_barrier(const XcdBarrier& b) {
    asm volatile("s_waitcnt vmcnt(0)" ::: "memory");
    __syncthreads();
    if (threadIdx.x == 0) {
        unsigned* bar = b.bar;
        __builtin_amdgcn_s_waitcnt(0);
        unsigned nloc = b.st[0], nx = b.st[1];
        if (nloc == 0u) { xcd_barrier_complete(bar, b.x, nloc, nx); b.st[0] = nloc; b.st[1] = nx; }
        const unsigned old = xb_add(&bar[XB_XSUB(b.x)], 1u);
        const unsigned gen = old / nloc;
        if (old + 1u == (gen + 1u) * nloc) {
            __builtin_amdgcn_fence(__ATOMIC_RELEASE, "agent");
            asm volatile("s_waitcnt vmcnt(0)" ::: "memory");
            const unsigned og = xb_add(&bar[XB_TOP], 1u);
            const unsigned tg = og / nx;
            asm volatile("buffer_inv sc1" ::: "memory");
            if (og + 1u != (tg + 1u) * nx) XB_SPIN(xb_ld(&bar[XB_TOP]) < (tg + 1u) * nx, bar);
            xb_add(&bar[XB_XGEN(b.x)], 1u);
            asm volatile("s_waitcnt vmcnt(0)" ::: "memory");
        } else {
            asm volatile("buffer_inv sc1" ::: "memory");
            XB_SPIN(xb_ld(&bar[XB_XGEN(b.x)]) == gen, bar);
            asm volatile("s_waitcnt vmcnt(0)" ::: "memory");
        }
    }
    __syncthreads();
}

struct Args { const float* in[24]; float* out; unsigned char* ws; int ph_lo, ph_hi; };
enum { IN_X = 0, IN_C, IN_RELB, IN_LBL, IN_WADA, IN_BADA, IN_NPRE, IN_NPOST, IN_WIN, IN_WGATE, IN_BGATE, IN_HNW, IN_CW, IN_CB, IN_CLG, IN_CLB,
       IN_WA, IN_WB, IN_WC, IN_WO, IN_MPRE, IN_MPOST, IN_WUP, IN_WDOWN };

struct Frame {
    LAS unsigned char* lds;
    int tid, lane, wave, G, bid;
    const Args* a;
    unsigned char* ws;
};

__device__ __forceinline__ float dpp_add(float v, const int ctrl_sel) {
    int x;
    if (ctrl_sel == 0) x = __builtin_amdgcn_update_dpp(0, __float_as_int(v), 0xB1, 0xf, 0xf, false);
    else if (ctrl_sel == 1) x = __builtin_amdgcn_update_dpp(0, __float_as_int(v), 0x4E, 0xf, 0xf, false);
    else if (ctrl_sel == 2) x = __builtin_amdgcn_update_dpp(0, __float_as_int(v), 0x141, 0xf, 0xf, false);
    else x = __builtin_amdgcn_update_dpp(0, __float_as_int(v), 0x140, 0xf, 0xf, false);
    return v + __int_as_float(x);
}
__device__ __forceinline__ float wave_sum(float v) {
    v = dpp_add(v, 0); v = dpp_add(v, 1); v = dpp_add(v, 2); v = dpp_add(v, 3);
    const float s0 = __int_as_float(__builtin_amdgcn_readlane(__float_as_int(v), 0)), s1 = __int_as_float(__builtin_amdgcn_readlane(__float_as_int(v), 16));
    const float s2 = __int_as_float(__builtin_amdgcn_readlane(__float_as_int(v), 32)), s3 = __int_as_float(__builtin_amdgcn_readlane(__float_as_int(v), 48));
    return (s0 + s1) + (s2 + s3);
}

struct TrItem { const float* src; bf16* dst; int N, ldt; };
__device__ __forceinline__ void tr_load(const TrItem& t, f32x4 (&v)[16], int lane) {
    const float* src = t.src + (size_t)(16 * (lane >> 4)) * t.N + 4 * (lane & 15);
#pragma unroll
    for (int i = 0; i < 16; ++i) v[i] = __builtin_nontemporal_load((const GAS f32x4*)(src + (size_t)i * t.N));
}
template <bool NTS> __device__ __forceinline__ void tr_finish(const TrItem& t, const f32x4 (&v)[16], LAS unsigned char* scr, int lane) {
    const int q = lane >> 4, p = lane & 15;
#pragma unroll
    for (int c = 0; c < 4; ++c) {
        v4u lo, hi;
        lo.x = pk2(v[0][c], v[1][c]); lo.y = pk2(v[2][c], v[3][c]); lo.z = pk2(v[4][c], v[5][c]); lo.w = pk2(v[6][c], v[7][c]);
        hi.x = pk2(v[8][c], v[9][c]); hi.y = pk2(v[10][c], v[11][c]); hi.z = pk2(v[12][c], v[13][c]); hi.w = pk2(v[14][c], v[15][c]);
        LAS unsigned char* d = scr + (4 * p + c) * 144 + q * 32;
        *(LAS v4u*)d = lo; *(LAS v4u*)(d + 16) = hi; }
    LDS_WAIT(); asm volatile("" ::: "memory");
#pragma unroll
    for (int j = 0; j < 8; ++j) { const int n = (lane >> 3) + 8 * j, ch = lane & 7;
        const v4u o = *(const LAS v4u*)(scr + n * 144 + ch * 16);
        if (NTS) __builtin_nontemporal_store(o, (GAS v4u*)(t.dst + (size_t)n * t.ldt + 8 * ch)); else *(GAS v4u*)(t.dst + (size_t)n * t.ldt + 8 * ch) = o; }
    LDS_WAIT(); asm volatile("" ::: "memory");
}

constexpr int TR_IN = 32 * 124, TR_GATE = 32 * 96, TR_A = 16 * 32, TR_B = 4 * 32, TR_C = 12 * 32, TR_O = 32 * 32, TR_UP = 32 * 128, TR_DOWN = 128 * 32;
constexpr int TR_PER_LAYER = TR_IN + TR_GATE + TR_A + TR_B + TR_C + TR_O + TR_UP + TR_DOWN, TR_FIRST = TR_IN + TR_GATE;
#ifndef TR_EXTRA_IN_PREP
#define TR_EXTRA_IN_PREP (TR_A + TR_B + TR_C + TR_O)
#endif
constexpr int TR_SPLIT = TR_FIRST + TR_EXTRA_IN_PREP;
constexpr int PREP_ITEMS = (G1_GEMM_CUS < 256) ? TR_SPLIT : 2 * TR_PER_LAYER;
__device__ __forceinline__ TrItem tr_decode(Frame& F, int it) {
    const Args& A = *F.a;
    const int l = it / TR_PER_LAYER; int r = it % TR_PER_LAYER;
    unsigned char* wl = F.ws + WS_W + (size_t)l * W_LAYER;
    const float* W; int N, ldt, row_off = 0, col_off = 0; bf16* WT;
    if (r < TR_IN) { W = A.in[IN_WIN] + (size_t)l * 2048 * NIN; N = NIN; WT = (bf16*)(wl + WO_CAT1); ldt = 2048; }
    else if ((r -= TR_IN) < TR_GATE) { W = A.in[IN_WGATE] + (size_t)l * 2048 * NGATE; N = NGATE; WT = (bf16*)(wl + WO_CAT1); ldt = 2048; row_off = NIN; }
    else if ((r -= TR_GATE) < TR_A) { W = A.in[IN_WA] + (size_t)l * 1024 * 2048; N = 2048; WT = (bf16*)(wl + WO_CAT2); ldt = 2048; }
    else if ((r -= TR_A) < TR_B) { W = A.in[IN_WB] + (size_t)l * 256 * 2048; N = 2048; WT = (bf16*)(wl + WO_CAT2); ldt = 2048; col_off = 1024; }
    else if ((r -= TR_B) < TR_C) { W = A.in[IN_WC] + (size_t)l * 768 * 2048; N = 2048; WT = (bf16*)(wl + WO_CAT2); ldt = 2048; col_off = 1280; }
    else if ((r -= TR_C) < TR_O) { W = A.in[IN_WO] + (size_t)l * 2048 * 2048; N = 2048; WT = (bf16*)(wl + WO_O); ldt = 2048; }
    else if ((r -= TR_O) < TR_UP) { W = A.in[IN_WUP] + (size_t)l * 2048 * 8192; N = 8192; WT = (bf16*)(wl + WO_UP); ldt = 2048; }
    else { r -= TR_UP; W = A.in[IN_WDOWN] + (size_t)l * 8192 * 2048; N = 2048; WT = (bf16*)(wl + WO_DOWN); ldt = 8192; }
    const int nblk = N / 64, kb = r / nblk, nb = r % nblk;
    int drow = row_off + 64 * nb;
    if (N == NIN && 64 * nb >= OFF_CA) {
        const int isg = (64 * nb >= OFF_CG) ? 1 : 0, ch = 64 * nb - (isg ? OFF_CG : OFF_CA);
        drow = OFF_CA + 256 * (ch >> 7) + 128 * isg + (ch & 127); }
    TrItem t; t.src = W + (size_t)(64 * kb) * N + 64 * nb; t.dst = WT + (size_t)drow * ldt + col_off + 64 * kb; t.N = N; t.ldt = ldt; return t;
}
template <bool NTS = false> __device__ __forceinline__ void transposes(Frame& F, int gw, int ngw, int lo_item, int hi_item) {
    LAS unsigned char* scr = F.lds + F.wave * 16384;
    for (int it = lo_item + gw; it < hi_item; it += 2 * ngw) {
        const bool two = (it + ngw) < hi_item;
        const TrItem t0 = tr_decode(F, it), t1 = tr_decode(F, two ? it + ngw : it);
        f32x4 v0[16], v1[16];
        tr_load(t0, v0, F.lane); if (two) tr_load(t1, v1, F.lane);
        tr_finish<NTS>(t0, v0, scr, F.lane); if (two) tr_finish<NTS>(t1, v1, scr, F.lane);
    }
}

__device__ __forceinline__ void gemv_items(Frame& F, int first, int last, int cb, int ncb) {
    const Args& A = *F.a;
    float* MOD = (float*)(F.ws + WS_MOD);
    LAS float* cact = (LAS float*)(F.lds);
    LAS float* red = (LAS float*)(F.lds + 32768);
    __syncthreads();
    for (int e = F.tid; e < 4 * 2048; e += NTHREADS) { const float c = A.in[IN_C][e]; cact[e] = c * sigm(c); }
    __syncthreads();
    for (int it = first + cb; it < last; it += ncb) {
        const int l = it / 384, cg = it % 384, c4 = F.tid & 7, kk = F.tid >> 3;
        const float* W = A.in[IN_WADA] + (size_t)l * 2048 * 12288 + cg * 32 + c4 * 4;
        float acc[4][4];
#pragma unroll
        for (int b = 0; b < 4; ++b)
#pragma unroll
            for (int j = 0; j < 4; ++j) acc[b][j] = 0.f;
#pragma unroll 1
        for (int k0 = kk; k0 < 2048; k0 += 64 * 16) {
            f32x4 wv[16];
#pragma unroll
            for (int u = 0; u < 16; ++u) wv[u] = __builtin_nontemporal_load((const GAS f32x4*)(W + (size_t)(k0 + 64 * u) * 12288));
#pragma unroll
            for (int u = 0; u < 16; ++u) {
#pragma unroll
                for (int b = 0; b < 4; ++b) { const float cv = cact[b * 2048 + k0 + 64 * u];
#pragma unroll
                    for (int j = 0; j < 4; ++j) acc[b][j] += cv * wv[u][j]; } }
        }
#pragma unroll
        for (int b = 0; b < 4; ++b)
#pragma unroll
            for (int j = 0; j < 4; ++j) red[(kk * 8 + c4) * 16 + b * 4 + j] = acc[b][j];
        __syncthreads();
        if (F.tid < 128) { const int b = F.tid >> 5, col = F.tid & 31, cc4 = col >> 2, j = col & 3; float sacc = 0.f;
            for (int q = 0; q < 64; ++q) sacc += red[(q * 8 + cc4) * 16 + b * 4 + j];
            __hip_atomic_store(&MOD[((size_t)l * 4 + b) * 12288 + cg * 32 + col], sacc + A.in[IN_BADA][l * 12288 + cg * 32 + col], __ATOMIC_RELAXED, __HIP_MEMORY_SCOPE_AGENT); }
        asm volatile("s_waitcnt vmcnt(0)" ::: "memory");
        __syncthreads();
        if (F.tid == 0) __hip_atomic_fetch_add((unsigned*)(F.ws + WS_CNT) + GEMV_CNT_WORD, 1u, __ATOMIC_RELAXED, __HIP_MEMORY_SCOPE_AGENT);
    }
}
#ifndef GEMV_FIRST_ITEMS
#define GEMV_FIRST_ITEMS 768
#endif
constexpr int GEMV_FIRST = GEMV_FIRST_ITEMS, GEMV_ALL = 768;
__device__ __forceinline__ void norm_phase(Frame& F, const float* xin, float* xout, const bf16* y, const float* g, const float* wpost, const float* wpre, const float* sc, const float* sh, bf16* H);
__device__ __forceinline__ void prep_phase(Frame& F) {
    const Args& A = *F.a;
    float* LB = (float*)(F.ws + WS_LB); float* BT = (float*)(F.ws + WS_BIAS);
    gemv_items(F, 0, (G1_GEMM_CUS < 256) ? GEMV_FIRST : GEMV_ALL, F.bid, F.G);
    if (F.bid == F.G - 1) {
        for (int k = F.tid; k < 1024; k += NTHREADS) {
            const float a0 = A.in[IN_LBL][k], a1 = A.in[IN_LBL][1024 + k], mx = fmaxf(a0, a1), e0 = expf(a0 - mx), e1 = expf(a1 - mx), s0 = e0 / (e0 + e1), s1 = e1 / (e0 + e1);
            LB[k] = fmaxf(s0 - s0, 0.f); LB[1024 + k] = fmaxf((s0 + s1) - s0, 0.f);
        }
        for (int e = F.tid; e < 3 * 4 * 129; e += NTHREADS) {
            const int g = e / (4 * 129), r = e % (4 * 129), sl = r / 129, j = r % 129; const int dil = g == 0 ? 1 : (g == 1 ? 4 : 16);
            const int dist = j * dil; int bucket;
            if (dist < 16) bucket = dist; else { const float dd = (float)dist; int large = 16 + (int)(logf(dd / 16.0f) / logf(128.0f) * 16.0f); bucket = large < 16 ? 16 : (large > 31 ? 31 : large); }
            BT[(g * 4 + sl) * 132 + j] = A.in[IN_RELB][bucket * 12 + g * 4 + sl];
        }
    }
    __syncthreads();
    transposes(F, F.bid * NWAVES + F.wave, F.G * NWAVES, 0, PREP_ITEMS);
    __syncthreads();
    if (F.tid == 0) { const unsigned want = (G1_GEMM_CUS < 256) ? (unsigned)GEMV_FIRST : (unsigned)GEMV_ALL; unsigned sp = 0;
        while (__hip_atomic_load((unsigned*)(F.ws + WS_CNT) + GEMV_CNT_WORD, __ATOMIC_RELAXED, __HIP_MEMORY_SCOPE_AGENT) < want) { __builtin_amdgcn_s_sleep(1); if (++sp > (1u << 22)) break; }
        __builtin_amdgcn_fence(__ATOMIC_ACQUIRE, "agent");
        asm volatile("s_waitcnt vmcnt(0)" ::: "memory"); }
    __syncthreads();
    { const float* MOD = (const float*)(F.ws + WS_MOD);
      norm_phase(F, A.in[IN_X], nullptr, nullptr, nullptr, nullptr, A.in[IN_NPRE], MOD + 1 * 2048, MOD + 0 * 2048, (bf16*)(F.ws + WS_H)); }
}

__device__ __forceinline__ void norm_phase(Frame& F, const float* xin, float* xout, const bf16* y, const float* g  , const float* wpost,
                                           const float* wpre, const float* sc, const float* sh, bf16* H) {
    const int gw = F.bid * NWAVES + F.wave, NGW = F.G * NWAVES;
    for (int m0 = 2 * gw; m0 < M; m0 += 2 * NGW) {
        const int b = m0 / SEQ;
        f32x4 v[2][8]; v4u yw[2][4];
#pragma unroll
        for (int r = 0; r < 2; ++r) { const GAS f32x4* xr = (const GAS f32x4*)(xin + (size_t)(m0 + r) * DM) + 2 * F.lane;
#pragma unroll
            for (int j = 0; j < 4; ++j) { v[r][2 * j] = xr[128 * j]; v[r][2 * j + 1] = xr[128 * j + 1]; }
            if (y) { const GAS v4u* yr = (const GAS v4u*)(y + (size_t)(m0 + r) * DM) + F.lane;
#pragma unroll
                for (int j = 0; j < 4; ++j) yw[r][j] = yr[64 * j]; } }
#pragma unroll
        for (int r = 0; r < 2; ++r) {
            const int m = m0 + r;
            if (y) {
                f32x4 yv[8]; float ss = 0.f;
#pragma unroll
                for (int j = 0; j < 4; ++j) { const v4u w = yw[r][j]; yv[2 * j] = (f32x4){bflo(w.x), bfhi(w.x), bflo(w.y), bfhi(w.y)}; yv[2 * j + 1] = (f32x4){bflo(w.z), bfhi(w.z), bflo(w.w), bfhi(w.w)}; }
#pragma unroll
                for (int j = 0; j < 8; ++j) ss += (yv[j].x * yv[j].x + yv[j].y * yv[j].y) + (yv[j].z * yv[j].z + yv[j].w * yv[j].w);
                const float rr = __builtin_amdgcn_rsqf(wave_sum(ss) * (1.0f / DM) + EPS);
#pragma unroll
                for (int j = 0; j < 8; ++j) { const int col = 8 * F.lane + 512 * (j >> 1) + 4 * (j & 1);
                    const f32x4 gg = *(const GAS f32x4*)(g + (size_t)b * 12288 + col), wp = *(const GAS f32x4*)(wpost + col);
                    v[r][j] = v[r][j] + gg * (yv[j] * rr * wp); }
            }
            if (xout) { GAS f32x4* xo = (GAS f32x4*)(xout + (size_t)m * DM) + 2 * F.lane;
#pragma unroll
                for (int j = 0; j < 4; ++j) { xo[128 * j] = v[r][2 * j]; xo[128 * j + 1] = v[r][2 * j + 1]; } }
            if (wpre) {
                float ss = 0.f;
#pragma unroll
                for (int j = 0; j < 8; ++j) ss += (v[r][j].x * v[r][j].x + v[r][j].y * v[r][j].y) + (v[r][j].z * v[r][j].z + v[r][j].w * v[r][j].w);
                const float rr = __builtin_amdgcn_rsqf(wave_sum(ss) * (1.0f / DM) + EPS);
                GAS v4u* ho = (GAS v4u*)(H + (size_t)m * DM) + F.lane;
#pragma unroll
                for (int j = 0; j < 4; ++j) { const int col = 8 * F.lane + 512 * j; v4u o;
                    { const f32x4 wp = *(const GAS f32x4*)(wpre + col), s1 = *(const GAS f32x4*)(sc + (size_t)b * 12288 + col), s0 = *(const GAS f32x4*)(sh + (size_t)b * 12288 + col);
                      const f32x4 h = (v[r][2 * j] * rr * wp) * (s1 + 1.0f) + s0; o.x = pk2(h.x, h.y); o.y = pk2(h.z, h.w); }
                    { const f32x4 wp = *(const GAS f32x4*)(wpre + col + 4), s1 = *(const GAS f32x4*)(sc + (size_t)b * 12288 + col + 4), s0 = *(const GAS f32x4*)(sh + (size_t)b * 12288 + col + 4);
                      const f32x4 h = (v[r][2 * j + 1] * rr * wp) * (s1 + 1.0f) + s0; o.z = pk2(h.x, h.y); o.w = pk2(h.z, h.w); }
                    ho[64 * j] = o; }
            }
        }
    }
}

__device__ __forceinline__ void conv_phase(Frame& F, int l, bf16* YC) {
    const Args& A = *F.a;
    const bf16* INP = (const bf16*)(F.ws + WS_INP);
    const float* CW = A.in[IN_CW] + (size_t)l * 31 * 768; const float* CB = A.in[IN_CB] + l * 768; const float* LG = A.in[IN_CLG] + l * 768; const float* LBt = A.in[IN_CLB] + l * 768;
    LAS float* U = (LAS float*)(F.lds);
    LAS float* red = (LAS float*)(F.lds + 46 * 768 * 4);
    LAS float* fin = red + 6 * 32;
    for (int it = F.bid; it < 512; it += F.G) {
        const int b = it >> 7, t0 = (it & 127) * 16;
        __syncthreads();
#pragma unroll 1
        for (int q0 = 0; q0 < 9; q0 += 3) {
            v4u aw[3];
#pragma unroll
            for (int q = 0; q < 3; ++q) { const int e = F.tid + (q0 + q) * NTHREADS, r = e / 96, c8 = (e - r * 96) * 8, t = t0 - 30 + r;
                aw[q] = (v4u){0u, 0u, 0u, 0u};
                if (e < 46 * 96 && t >= 0) aw[q] = *(const GAS v4u*)(INP + ((size_t)b * SEQ + t) * NIN + OFF_CA + c8); }
#pragma unroll
            for (int q = 0; q < 3; ++q) { const int e = F.tid + (q0 + q) * NTHREADS, r = e / 96, c8 = (e - r * 96) * 8;
                if (e < 46 * 96) { const f32x4 u0 = (f32x4){bflo(aw[q].x), bfhi(aw[q].x), bflo(aw[q].y), bfhi(aw[q].y)}, u1 = (f32x4){bflo(aw[q].z), bfhi(aw[q].z), bflo(aw[q].w), bfhi(aw[q].w)};
                    *(LAS f32x4*)(U + r * 768 + c8) = u0; *(LAS f32x4*)(U + r * 768 + c8 + 4) = u1; } }
        }
        __syncthreads();
        const bool act = F.tid < 384; const int c0 = act ? 2 * F.tid : 0;
        float acc[16][2];
        {
            float w[31][2];
#pragma unroll
            for (int j = 0; j < 31; ++j) { w[j][0] = CW[j * 768 + c0]; w[j][1] = CW[j * 768 + c0 + 1]; }
            const float b0 = CB[c0], b1 = CB[c0 + 1];
#pragma unroll
            for (int tt = 0; tt < 16; ++tt) { acc[tt][0] = b0; acc[tt][1] = b1; }
#pragma unroll
            for (int r = 0; r < 46; ++r) {
                const float u0 = U[r * 768 + c0], u1 = U[r * 768 + c0 + 1];
#pragma unroll
                for (int tt = 0; tt < 16; ++tt) { const int j = r - tt; if (j >= 0 && j <= 30) { acc[tt][0] += u0 * w[j][0]; acc[tt][1] += u1 * w[j][1]; } }
            }
        }
#pragma unroll
        for (int tt = 0; tt < 16; ++tt) {
            float sv = act ? (acc[tt][0] + acc[tt][1]) : 0.f, qv = act ? (acc[tt][0] * acc[tt][0] + acc[tt][1] * acc[tt][1]) : 0.f;
            sv = wave_sum(sv); qv = wave_sum(qv);
            if (F.lane == 0 && F.wave < 6) { red[F.wave * 32 + tt] = sv; red[F.wave * 32 + 16 + tt] = qv; }
        }
        __syncthreads();
        if (F.tid < 16) { float ts = 0.f, tq = 0.f;
#pragma unroll
            for (int w = 0; w < 6; ++w) { ts += red[w * 32 + F.tid]; tq += red[w * 32 + 16 + F.tid]; }
            const float mu = ts * (1.0f / 768.f), var = tq * (1.0f / 768.f) - mu * mu;
            fin[F.tid * 2] = mu; fin[F.tid * 2 + 1] = __builtin_amdgcn_rsqf(var + EPS); }
        __syncthreads();
        if (act) { int c0v = c0; asm volatile("" : "+v"(c0v));
            const float g0 = LG[c0v], g1 = LG[c0v + 1], bb0 = LBt[c0v], bb1 = LBt[c0v + 1];
            GAS unsigned* op = (GAS unsigned*)(YC + ((size_t)b * SEQ + t0) * DM + YC_C + c0v);
#pragma unroll
            for (int tt = 0; tt < 16; ++tt) { const f32x2 mr = *(const LAS f32x2*)(fin + tt * 2);
                const float a0 = (acc[tt][0] - mr.x) * mr.y * g0 + bb0, a1 = (acc[tt][1] - mr.x) * mr.y * g1 + bb1;
                op[tt * (DM / 2)] = pk2(a0 * sigm(a0), a1 * sigm(a1)); } }
    }
}

typedef short s16x4 __attribute__((ext_vector_type(4)));
typedef short s16x8 __attribute__((ext_vector_type(8)));
constexpr int ATT_KS = 144, ATT_VS = 160;
constexpr int ATT_K_OFF = 0, ATT_V_OFF = 256 * ATT_KS, ATT_B_OFF = ATT_V_OFF + 272 * ATT_VS;
typedef short v4i16_t __attribute__((ext_vector_type(4)));
__device__ __forceinline__ s16x4 lds_tr16(LAS unsigned char* p) { return __builtin_bit_cast(s16x4, __builtin_amdgcn_ds_read_tr16_b64_v4i16((LAS v4i16_t*)p)); }
struct AttItem { int g, b, s, r, qb, head, dil; };
__device__ __forceinline__ AttItem att_decode(int it) {
    AttItem a; a.g = it >> 8; const int rem = it & 255; a.b = rem >> 6; a.s = (rem >> 4) & 3; const int rq = rem & 15;
    const int dsh = 2 * a.g, nqbsh = 4 - dsh; a.dil = 1 << dsh;
    a.r = rq >> nqbsh; a.qb = rq & ((1 << nqbsh) - 1); a.head = 4 * a.g + a.s; return a;
}
__device__ __forceinline__ void att_load(Frame& F, const AttItem& a, v4u (&kv)[4], v4u (&vv)[4], v4u (&qv)[2], float& bs) {
    const bf16* INP = (const bf16*)(F.ws + WS_INP); const float* BT = (const float*)(F.ws + WS_BIAS);
#pragma unroll
    for (int i = 0; i < 4; ++i) { const int row = (F.tid >> 3) + 64 * i, ch = F.tid & 7; const int lp = 128 * (a.qb - 1) + row;
        kv[i] = (v4u){0u, 0u, 0u, 0u}; vv[i] = kv[i];
        if (lp >= 0) { const size_t ro = ((size_t)a.b * SEQ + (size_t)lp * a.dil + a.r) * NIN + a.head * 64 + ch * 8;
            kv[i] = *(const GAS v4u*)(INP + ro + OFF_BK); vv[i] = *(const GAS v4u*)(INP + ro + OFF_BV); } }
    const int lq = 128 * a.qb + 16 * F.wave + (F.lane & 15); const size_t qrow = (size_t)a.b * SEQ + (size_t)lq * a.dil + a.r;
#pragma unroll
    for (int ks = 0; ks < 2; ++ks) qv[ks] = *(const GAS v4u*)(INP + qrow * NIN + OFF_BQ + a.head * 64 + ks * 32 + (F.lane >> 4) * 8);
    bs = (F.tid < 129) ? BT[(a.g * 4 + a.s) * 132 + F.tid] : 0.f;
}
__device__ __forceinline__ void attn_phase(Frame& F) {
    float* AO = (float*)(F.ws + WS_ATTO); float* AL = (float*)(F.ws + WS_ATTL);
    LAS unsigned char* Ks = F.lds + ATT_K_OFF; LAS unsigned char* Vs = F.lds + ATT_V_OFF; LAS float* Bs = (LAS float*)(F.lds + ATT_B_OFF);
    const int w = F.wave, qcol = F.lane & 15, g4 = F.lane >> 4;
    int it = F.bid;
    if (it >= 768) return;
    AttItem cur = att_decode(it);
    v4u kvr[4], vvr[4], qvr[2]; float bsr;
    att_load(F, cur, kvr, vvr, qvr, bsr);
    for (; it < 768; it += F.G) {
        const int g = cur.g, b = cur.b, s = cur.s, r = cur.r, qb = cur.qb, dil = cur.dil;
        __syncthreads();
#pragma unroll
        for (int i = 0; i < 4; ++i) { const int row = (F.tid >> 3) + 64 * i, ch = F.tid & 7;
            *(LAS v4u*)(Ks + row * ATT_KS + ch * 16) = kvr[i]; *(LAS v4u*)(Vs + row * ATT_VS + ch * 16) = vvr[i]; }
        if (F.tid < 128) *(LAS v4u*)(Vs + (256 + (F.tid >> 3)) * ATT_VS + (F.tid & 7) * 16) = (v4u){0u, 0u, 0u, 0u};
        if (F.tid < 129) Bs[F.tid] = bsr;
        const int lq = 128 * qb + 16 * w + qcol; const size_t qrow = (size_t)b * SEQ + (size_t)lq * dil + r;
        s16x8 qf[2];
#pragma unroll
        for (int ks = 0; ks < 2; ++ks) qf[ks] = __builtin_bit_cast(s16x8, qvr[ks]);
        __syncthreads();
        if (it + F.G < 768) { cur = att_decode(it + F.G); att_load(F, cur, kvr, vvr, qvr, bsr); }
        float sc[9][4];
#pragma unroll
        for (int i = 0; i < 9; ++i) {
            pg8::f32x4 a4 = (pg8::f32x4){0.f, 0.f, 0.f, 0.f};
#pragma unroll
            for (int ks = 0; ks < 2; ++ks) { const s16x8 kf = *(const LAS s16x8*)(Ks + (16 * (w + i) + qcol) * ATT_KS + ks * 64 + g4 * 16);
                a4 = __builtin_amdgcn_mfma_f32_16x16x32_bf16(kf, qf[ks], a4, 0, 0, 0); }
#pragma unroll
            for (int rg = 0; rg < 4; ++rg) { const int keyrow = 4 * g4 + rg; const int j = 128 - 16 * i + qcol - keyrow;
                const int lp = 128 * (qb - 1) + 16 * (w + i) + keyrow;
                const bool valid = (j >= 0) && (j <= 128) && (lp >= 0);
                const float bias = Bs[valid ? j : 0];
                sc[i][rg] = valid ? (a4[rg] * 0.125f + bias) : -1e30f; }
        }
        float mx = -1e30f;
#pragma unroll
        for (int i = 0; i < 9; ++i)
#pragma unroll
            for (int rg = 0; rg < 4; ++rg) mx = fmaxf(mx, sc[i][rg]);
        mx = fmaxf(mx, __shfl_xor(mx, 16)); mx = fmaxf(mx, __shfl_xor(mx, 32));
        float z = 0.f; unsigned pp[10][2];
#pragma unroll
        for (int i = 0; i < 9; ++i) { float p[4];
#pragma unroll
            for (int rg = 0; rg < 4; ++rg) { p[rg] = __expf(sc[i][rg] - mx); z += p[rg]; }
            pp[i][0] = pk2(p[0], p[1]); pp[i][1] = pk2(p[2], p[3]); }
        pp[9][0] = 0u; pp[9][1] = 0u;
        z += __shfl_xor(z, 16); z += __shfl_xor(z, 32);
        pg8::f32x4 oa[4];
#pragma unroll
        for (int dt = 0; dt < 4; ++dt) oa[dt] = (pg8::f32x4){0.f, 0.f, 0.f, 0.f};
#pragma unroll
        for (int c = 0; c < 5; ++c) {
            v4u pw; pw.x = pp[2 * c][0]; pw.y = pp[2 * c][1]; pw.z = pp[2 * c + 1][0]; pw.w = pp[2 * c + 1][1];
            const s16x8 pf = __builtin_bit_cast(s16x8, pw);
#pragma unroll
            for (int dt = 0; dt < 4; ++dt) {
                LAS unsigned char* va = Vs + (16 * (w + 2 * c) + 4 * g4 + (qcol >> 2)) * ATT_VS + (16 * dt + 4 * (qcol & 3)) * 2;
                const s16x4 v0 = lds_tr16(va), v1 = lds_tr16(va + 16 * ATT_VS);
                const s16x8 vf = (s16x8){v0[0], v0[1], v0[2], v0[3], v1[0], v1[1], v1[2], v1[3]};
                oa[dt] = __builtin_amdgcn_mfma_f32_16x16x32_bf16(vf, pf, oa[dt], 0, 0, 0);
            }
        }
        const float iz = 1.0f / z;
        float* op = AO + ((size_t)g * M + qrow) * 256 + s * 64 + 4 * g4;
#pragma unroll
        for (int dt = 0; dt < 4; ++dt) *(GAS f32x4*)(op + 16 * dt) = oa[dt] * iz;
        if (g4 == 0) AL[((size_t)g * M + qrow) * 4 + s] = mx + __logf(z);
    }
}
__device__ __forceinline__ void attn_combine_phase(Frame& F, bf16* YC) {
    const float* AO = (const float*)(F.ws + WS_ATTO); const float* AL = (const float*)(F.ws + WS_ATTL);
    for (int id = F.bid * NTHREADS + F.tid; id < M * 32; id += F.G * NTHREADS) {
        const int c8 = id & 31, row = id >> 5, s = c8 >> 3;
        const float l0 = AL[((size_t)0 * M + row) * 4 + s], l1 = AL[((size_t)1 * M + row) * 4 + s], l2 = AL[((size_t)2 * M + row) * 4 + s];
        const float mx = fmaxf(l0, fmaxf(l1, l2)); const float e0 = __expf(l0 - mx), e1 = __expf(l1 - mx), e2 = __expf(l2 - mx), inv = 1.0f / (e0 + e1 + e2);
        f32x4 a = (f32x4){0.f, 0.f, 0.f, 0.f}, bq = a;
        { const GAS f32x4* p = (const GAS f32x4*)(AO + ((size_t)0 * M + row) * 256 + c8 * 8); a = a + p[0] * (e0 * inv); bq = bq + p[1] * (e0 * inv); }
        { const GAS f32x4* p = (const GAS f32x4*)(AO + ((size_t)1 * M + row) * 256 + c8 * 8); a = a + p[0] * (e1 * inv); bq = bq + p[1] * (e1 * inv); }
        { const GAS f32x4* p = (const GAS f32x4*)(AO + ((size_t)2 * M + row) * 256 + c8 * 8); a = a + p[0] * (e2 * inv); bq = bq + p[1] * (e2 * inv); }
        v4u o; o.x = pk2(a.x, a.y); o.y = pk2(a.z, a.w); o.z = pk2(bq.x, bq.y); o.w = pk2(bq.z, bq.w);
        *(GAS v4u*)(YC + (size_t)row * DM + YC_B + c8 * 8) = o;
    }
}


constexpr int HG_QD = 0, HG_KINV = 17408, HG_KDT = 34816, HG_VS = 52224, HG_DEC = 70656, HG_O = 72704;
__device__ __forceinline__ s16x4 pack4(float a, float b, float c, float d) { v2u w; w.x = pk2(a, b); w.y = pk2(c, d); return __builtin_bit_cast(s16x4, w); }
template <bool OUT> __device__ __forceinline__ void hgrn_group_phase(Frame& F, int l, bf16* YC) {
    const Args& A = *F.a;
    const bf16* INP = (const bf16*)(F.ws + WS_INP);
    float* HS = (float*)(F.ws + WS_HSTATE); float* HD = (float*)(F.ws + WS_HDEC);
    const float* LB = (const float*)(F.ws + WS_LB) + l * 1024; const float* NW = A.in[IN_HNW] + l * 128;
    LAS unsigned char* QD = F.lds + HG_QD; LAS unsigned char* KINV = F.lds + HG_KINV; LAS unsigned char* KDT = F.lds + HG_KDT; LAS unsigned char* VS = F.lds + HG_VS;
    LAS float* DEC = (LAS float*)(F.lds + HG_DEC); LAS float* OB = (LAS float*)(F.lds + HG_O);
    const int w = F.wave, li = F.lane & 15, g4 = F.lane >> 4;
    const int pk = F.tid & 127, pi = F.tid >> 7;
    for (int it0 = F.bid; it0 < 256; it0 += F.G) {
        const int grp = OUT ? (it0 >> 3) & 7 : it0 & 7, bh = OUT ? (it0 & 7) | ((it0 >> 6) << 3) : it0 >> 3, it = bh * 8 + grp, b = bh >> 3, h = bh & 7;
        pg8::f32x4 R[8];
#pragma unroll
        for (int kb = 0; kb < 8; ++kb) R[kb] = (pg8::f32x4){0.f, 0.f, 0.f, 0.f};
        if (OUT && grp > 0) {
            LAS float* PL = OB;
            __syncthreads();
            if (F.tid < 128) {
                float d[7];
#pragma unroll
                for (int j = 0; j < 7; ++j) d[j] = HD[(size_t)(bh * 8 + (j < grp ? j : 0)) * 128 + F.tid];
                float p = 1.f;
#pragma unroll
                for (int j = 8; j >= 0; --j) { const bool on = j < grp; PL[j * 128 + F.tid] = on ? p : 0.f; if (on) p *= d[j < 7 ? j : 0]; }
            }
            __syncthreads();
            const float* hb = HS + (size_t)(bh * 8) * 16384 + F.tid * 4;
            f32x4 x0[8], x1[8], x2[8];
#define HG_LOADJ(x, j) { const int jj = (j) < grp ? (j) : grp - 1; const float* p_ = hb + (size_t)jj * 16384; _Pragma("unroll") for (int kb = 0; kb < 8; ++kb) x[kb] = *(const GAS f32x4*)(p_ + kb * 2048); }
#define HG_CONS(x, j) { _Pragma("unroll") for (int kb = 0; kb < 8; ++kb) { const f32x4 pv = *(const LAS f32x4*)(PL + (j) * 128 + 16 * kb + 4 * g4); R[kb] = R[kb] + pv * x[kb]; } }
            HG_LOADJ(x0, 0) HG_LOADJ(x1, 1) HG_LOADJ(x2, 2)
#pragma unroll 1
            for (int j = 0; j < grp; j += 3) {
                HG_CONS(x0, j) HG_LOADJ(x0, j + 3)
                HG_CONS(x1, j + 1) HG_LOADJ(x1, j + 4)
                HG_CONS(x2, j + 2) HG_LOADJ(x2, j + 5)
            }
#undef HG_LOADJ
#undef HG_CONS
        }
        float decp = 1.0f;
        const float lbk = LB[h * 128 + pk];
#pragma unroll 1
        for (int c4 = 0; c4 < 4; ++c4) {
            const size_t row0 = (size_t)b * SEQ + 256 * grp + 64 * c4;
            __syncthreads();
#pragma unroll
            for (int i = 0; i < 2; ++i) { const int e = F.tid + 512 * i, r = e >> 4, ch = e & 15;
                *(LAS v4u*)(VS + r * 288 + ch * 16) = *(const GAS v4u*)(INP + (row0 + r) * NIN + OFF_AI + h * 128 + ch * 8); }
            {
                float c[16], kk[16], qs[16];
                bf16 zr[16], qr[16];
#pragma unroll
                for (int t = 0; t < 16; ++t) { const size_t ro = (row0 + 16 * pi + t) * NIN + h * 128 + pk; zr[t] = INP[ro + OFF_AF]; if (OUT) qr[t] = INP[ro + OFF_AQ]; }
                float run = 1.f;
#pragma unroll
                for (int t = 0; t < 16; ++t) { const float kt = (1.f - lbk) * bf2f(zr[t]); const float f = 1.f - kt; run *= f; c[t] = run; kk[t] = kt;
                    qs[t] = f;
                }
                DEC[pi * 128 + pk] = c[15];
                {
                    float sx[16]; float suf = 1.f;
#pragma unroll
                    for (int t = 15; t >= 0; --t) { sx[t] = suf; suf *= qs[t]; }
#pragma unroll
                    for (int t = 0; t < 16; t += 4) {
                        const s16x4 kd = pack4(kk[t] * sx[t], kk[t + 1] * sx[t + 1], kk[t + 2] * sx[t + 2], kk[t + 3] * sx[t + 3]);
                        *(LAS s16x4*)(KDT + pk * 136 + pi * 32 + t * 2) = kd; }
                }
                if (OUT) {
#pragma unroll
                    for (int t = 0; t < 16; t += 2) {
                        const float q0 = bf2f(qr[t]), q1 = bf2f(qr[t + 1]);
                        const unsigned qd2 = pk2(q0 * c[t], q1 * c[t + 1]);
                        const unsigned ki2 = pk2(kk[t] * __builtin_amdgcn_rcpf(fmaxf(c[t], 1e-35f)), kk[t + 1] * __builtin_amdgcn_rcpf(fmaxf(c[t + 1], 1e-35f)));
                        *(LAS bf16*)(QD + (16 * pi + t) * 272 + pk * 2) = (bf16)(qd2 & 0xffffu); *(LAS bf16*)(QD + (16 * pi + t + 1) * 272 + pk * 2) = (bf16)(qd2 >> 16);
                        *(LAS bf16*)(KINV + (16 * pi + t) * 272 + pk * 2) = (bf16)(ki2 & 0xffffu); *(LAS bf16*)(KINV + (16 * pi + t + 1) * 272 + pk * 2) = (bf16)(ki2 >> 16); }
                }
            }
            unsigned ogw[8];
            if (OUT) {
#pragma unroll
                for (int q8 = 0; q8 < 8; ++q8) ogw[q8] = *(const GAS unsigned*)(INP + (row0 + 8 * w + q8) * NIN + OFF_AG + h * 128 + 2 * F.lane);
            }
            __syncthreads();
            if (!OUT && F.tid < 128) decp *= (DEC[F.tid] * DEC[128 + F.tid]) * (DEC[256 + F.tid] * DEC[384 + F.tid]);
#pragma unroll 1
            for (int i = 0; i < 4; ++i) {
                const s16x4 vf = lds_tr16(VS + (16 * i + 4 * g4 + (li >> 2)) * 288 + (16 * w + 4 * (li & 3)) * 2);
                if (OUT) {
                    pg8::f32x4 ad = (pg8::f32x4){0.f, 0.f, 0.f, 0.f}; s16x4 qf[8], kf[8];
#pragma unroll
                    for (int kb = 0; kb < 8; ++kb) { kf[kb] = *(const LAS s16x4*)(KINV + (16 * i + li) * 272 + (16 * kb + 4 * g4) * 2);
                        qf[kb] = *(const LAS s16x4*)(QD + (16 * i + li) * 272 + (16 * kb + 4 * g4) * 2); }
                    __builtin_amdgcn_sched_barrier(0);
#pragma unroll
                    for (int kp = 0; kp < 4; ++kp) ad = __builtin_amdgcn_mfma_f32_16x16x32_bf16(__builtin_shufflevector(kf[2 * kp], kf[2 * kp + 1], 0, 1, 2, 3, 4, 5, 6, 7), __builtin_shufflevector(qf[2 * kp], qf[2 * kp + 1], 0, 1, 2, 3, 4, 5, 6, 7), ad, 0, 0, 0);
#pragma unroll
                    for (int rg = 0; rg < 4; ++rg) if (4 * g4 + rg > li) ad[rg] = 0.f;
                    const s16x4 adf = pack4(ad[0], ad[1], ad[2], ad[3]);
                    const s16x4 z4 = (s16x4){0, 0, 0, 0};
                    pg8::f32x4 oT = __builtin_amdgcn_mfma_f32_16x16x32_bf16(__builtin_shufflevector(vf, z4, 0, 1, 2, 3, 4, 5, 6, 7), __builtin_shufflevector(adf, z4, 0, 1, 2, 3, 4, 5, 6, 7), (pg8::f32x4){0.f, 0.f, 0.f, 0.f}, 0, 0, 0);
#pragma unroll
                    for (int kp = 0; kp < 4; ++kp) { const s16x4 r0 = pack4(R[2 * kp][0], R[2 * kp][1], R[2 * kp][2], R[2 * kp][3]), r1 = pack4(R[2 * kp + 1][0], R[2 * kp + 1][1], R[2 * kp + 1][2], R[2 * kp + 1][3]);
                        oT = __builtin_amdgcn_mfma_f32_16x16x32_bf16(__builtin_shufflevector(r0, r1, 0, 1, 2, 3, 4, 5, 6, 7), __builtin_shufflevector(qf[2 * kp], qf[2 * kp + 1], 0, 1, 2, 3, 4, 5, 6, 7), oT, 0, 0, 0); }
                    *(LAS pg8::f32x4*)(OB + (16 * i + li) * 132 + 16 * w + 4 * g4) = oT;
                }
#pragma unroll
                for (int kb = 0; kb < 8; ++kb) { const pg8::f32x4 dv = *(const LAS pg8::f32x4*)(DEC + i * 128 + 16 * kb + 4 * g4);
                    const s16x4 kdf = *(const LAS s16x4*)(KDT + (16 * kb + li) * 136 + i * 32 + g4 * 8);
                    R[kb] = __builtin_amdgcn_mfma_f32_16x16x16bf16_1k(kdf, vf, R[kb] * dv, 0, 0, 0); }
            }
            if (OUT) {
                const float nw0 = NW[2 * F.lane], nw1 = NW[2 * F.lane + 1];
                __syncthreads();
#pragma unroll
                for (int q8 = 0; q8 < 8; ++q8) { const int t = 8 * w + q8; const size_t row = row0 + t;
                    const float o1 = OB[t * 132 + 2 * F.lane], o2 = OB[t * 132 + 2 * F.lane + 1];
                    const float r = __builtin_amdgcn_rsqf(wave_sum(o1 * o1 + o2 * o2) * (1.0f / 128.f) + EPS);
                    const float g1 = bflo(ogw[q8]), g2 = bfhi(ogw[q8]);
                    *(GAS unsigned*)(YC + row * DM + YC_A + h * 128 + 2 * F.lane) = pk2(o1 * r * nw0 * g1, o2 * r * nw1 * g2); }
            }
        }
        if (!OUT) {
            float* hs = HS + (size_t)it * 16384 + F.tid * 4;
#pragma unroll
            for (int kb = 0; kb < 8; ++kb) *(GAS pg8::f32x4*)(hs + kb * 2048) = R[kb];
            if (F.tid < 128) HD[(size_t)it * 128 + F.tid] = decp;
        }
    }
}

constexpr int N_PHASES = 1 + 7 * DEPTH;
#define IN(p) (lo <= (p) && (p) < hi)
#define SEAM(p) do { if ((p) + 1 < hi) xcd_barrier(bar); } while (0)
template <int L> __device__ __forceinline__ void layer_phases(Frame& F, const Args& args, const int lo, const int hi, const XcdBarrier& bar) {
    constexpr int P0 = 1 + 7 * L;
    if (IN(P0 + 0)) {
        unsigned char* wl = F.ws + WS_W + (size_t)L * W_LAYER;
        const int NG = (L == 0 && F.G > G1_GEMM_CUS) ? G1_GEMM_CUS : F.G;
        if (F.bid < NG) {
            pg8::Gemm g{(const bf16*)(F.ws + WS_H), (const bf16*)(wl + WO_CAT1), DM, DM}; pg8::StaticOrder S; S.init(M, N1, DM, NG, F.bid);
            pg8::EpiInGate E{(bf16*)(F.ws + WS_INP), (bf16*)(F.ws + WS_GATES), args.in[IN_BGATE] + L * NGATE};
            pg8::gemm_phase<pg8::EpiInGate, pg8::StaticOrder>(F.lds + RING_OFF, g, S, E);
        } else if (L == 0) { if (GEMV_FIRST < GEMV_ALL) gemv_items(F, GEMV_FIRST, GEMV_ALL, F.bid - NG, F.G - NG); transposes<true>(F, (F.bid - NG) * NWAVES + F.wave, (F.G - NG) * NWAVES, TR_SPLIT, 2 * TR_PER_LAYER); }
        SEAM(P0 + 0);
    }
    if (IN(P0 + 1)) {
        const int rot = F.bid % 3;
        if (rot == 0) { hgrn_group_phase<false>(F, L, nullptr); __syncthreads(); attn_phase(F); __syncthreads(); conv_phase(F, L, (bf16*)(F.ws + WS_YCAT)); }
        else if (rot == 1) { attn_phase(F); __syncthreads(); conv_phase(F, L, (bf16*)(F.ws + WS_YCAT)); __syncthreads(); hgrn_group_phase<false>(F, L, nullptr); }
        else { conv_phase(F, L, (bf16*)(F.ws + WS_YCAT)); __syncthreads(); hgrn_group_phase<false>(F, L, nullptr); __syncthreads(); attn_phase(F); }
        SEAM(P0 + 1);
    }
    if (IN(P0 + 2)) {
        hgrn_group_phase<true>(F, L, (bf16*)(F.ws + WS_YCAT)); __syncthreads(); attn_combine_phase(F, (bf16*)(F.ws + WS_YCAT));
        SEAM(P0 + 2);
    }
    if (IN(P0 + 3)) {
        unsigned char* wl = F.ws + WS_W + (size_t)L * W_LAYER;
        pg8::Gemm g{(const bf16*)(F.ws + WS_YCAT), (const bf16*)(wl + WO_CAT2), DM, DM}; pg8::SegOrder3 S; S.init(M, DM, F.G, F.bid);
        pg8::EpiMerge E{(bf16*)(F.ws + WS_MERGED), (const bf16*)(F.ws + WS_GATES)};
        pg8::gemm_phase<pg8::EpiMerge, pg8::SegOrder3>(F.lds + RING_OFF, g, S, E);
        SEAM(P0 + 3);
    }
    if (IN(P0 + 4)) {
        unsigned char* wl = F.ws + WS_W + (size_t)L * W_LAYER;
        const float* modl = (const float*)(F.ws + WS_MOD) + (size_t)L * 4 * 12288;
        pg8::Gemm g{(const bf16*)(F.ws + WS_MERGED), (const bf16*)(wl + WO_O), DM, DM}; pg8::StaticOrder S; S.init(M, DM, DM, F.G, F.bid);
        float* XS = (float*)(F.ws + WS_XS) + (size_t)(L * 2 + 0) * 2 * 65536; unsigned* CN = (unsigned*)(F.ws + WS_CNT) + (L * 2 + 0) * 2 * 2048;
        pg8::EpiNormFused E{L == 0 ? args.in[IN_X] : args.out, args.out, (bf16*)(F.ws + WS_H), modl + 2 * 2048, args.in[IN_NPOST] + L * DM, args.in[IN_MPRE] + L * DM, modl + 4 * 2048, modl + 3 * 2048,
                            XS, XS + 65536, CN, CN + 2048};
        pg8::gemm_phase<pg8::EpiNormFused, pg8::StaticOrder>(F.lds + RING_OFF, g, S, E);
        SEAM(P0 + 4);
    }
    if (IN(P0 + 5)) {
        unsigned char* wl = F.ws + WS_W + (size_t)L * W_LAYER;
        pg8::Gemm g{(const bf16*)(F.ws + WS_H), (const bf16*)(wl + WO_UP), DM, DM}; pg8::StaticOrder S; S.init(M, DFF, DM, F.G, F.bid);
        pg8::EpiRelu2 E{(bf16*)(F.ws + WS_U), DFF};
        pg8::gemm_phase<pg8::EpiRelu2, pg8::StaticOrder>(F.lds + RING_OFF, g, S, E);
        SEAM(P0 + 5);
    }
    if (IN(P0 + 6)) {
        unsigned char* wl = F.ws + WS_W + (size_t)L * W_LAYER;
        const float* modl = (const float*)(F.ws + WS_MOD) + (size_t)L * 4 * 12288;
        const float* modn = (const float*)(F.ws + WS_MOD) + (size_t)(L + 1) * 4 * 12288;
        constexpr bool lastl = (L == DEPTH - 1);
        pg8::Gemm g{(const bf16*)(F.ws + WS_U), (const bf16*)(wl + WO_DOWN), DFF, DFF}; pg8::StaticOrder S; S.init(M, DM, DFF, F.G, F.bid);
        float* XS = (float*)(F.ws + WS_XS) + (size_t)(L * 2 + 1) * 2 * 65536; unsigned* CN = (unsigned*)(F.ws + WS_CNT) + (L * 2 + 1) * 2 * 2048;
        pg8::EpiNormFused E{args.out, args.out, (bf16*)(F.ws + WS_H), modl + 5 * 2048, args.in[IN_MPOST] + L * DM, lastl ? nullptr : args.in[IN_NPRE] + (lastl ? 0 : (L + 1)) * DM, modn + 1 * 2048, modn + 0 * 2048,
                            XS, XS + 65536, CN, CN + 2048};
        pg8::gemm_phase<pg8::EpiNormFused, pg8::StaticOrder>(F.lds + RING_OFF, g, S, E);
        SEAM(P0 + 6);
    }
}
__global__ void __launch_bounds__(NTHREADS, 2) mk_fwd(Args args) {
    extern __shared__ __attribute__((aligned(16))) unsigned char lds[];
    Frame F;
    F.lds = (LAS unsigned char*)lds; F.tid = threadIdx.x; F.lane = F.tid & 63; F.wave = __builtin_amdgcn_readfirstlane(F.tid >> 6);
    F.G = gridDim.x; F.bid = blockIdx.x; F.a = &args; F.ws = args.ws;
    volatile LAS unsigned* MISC = (volatile LAS unsigned*)(F.lds + MISC_OFF);
    if (F.tid < 32) MISC[F.tid] = 0u;
    __syncthreads();
    const int lo = args.ph_lo, hi = args.ph_hi;
    XcdBarrier bar; bar.bar = (unsigned*)(F.ws + WS_CTL) + 4096; bar.x = 0; bar.st = nullptr;
    if (hi - lo > 1) bar = xcd_barrier_post((unsigned*)(F.ws + WS_CTL) + 4096, MISC + 8);
    if (IN(0)) { prep_phase(F); SEAM(0); }
    layer_phases<0>(F, args, lo, hi, bar);
    layer_phases<1>(F, args, lo, hi, bar);
}

extern "C" void kernel_launch(void* const* d_in, const int* in_sizes, int n_in, void* d_out, int out_size, void* d_ws, size_t ws_size, hipStream_t stream) {
    static int grid = 0;
    if (grid == 0) {
        if (n_in != 24 || out_size != M * DM || ws_size < WS_END) { fprintf(stderr, "kernel_launch: unexpected problem (n_in %d, out %d, ws %zu)\n", n_in, out_size, ws_size); grid = -1; return; }
        int dev = 0, cus = 0, per_cu = 0;
        if (hipGetDevice(&dev) != hipSuccess || hipDeviceGetAttribute(&cus, hipDeviceAttributeMultiprocessorCount, dev) != hipSuccess) { grid = -1; return; }
        if (hipFuncSetAttribute((const void*)mk_fwd, hipFuncAttributeMaxDynamicSharedMemorySize, LDS_BYTES) != hipSuccess) { fprintf(stderr, "kernel_launch: hipFuncSetAttribute failed\n"); grid = -1; return; }
        if (hipOccupancyMaxActiveBlocksPerMultiprocessor(&per_cu, (const void*)mk_fwd, NTHREADS, LDS_BYTES) != hipSuccess || per_cu < 1) { fprintf(stderr, "kernel_launch: occupancy query says %d blocks/CU\n", per_cu); grid = -1; (void)hipGetLastError(); return; }
        grid = cus;
    }
    if (grid < 0) return;
    (void)hipMemsetAsync((char*)d_ws + WS_CTL, 0, CTL_ZERO_BYTES, stream);
    Args a{};
    for (int i = 0; i < 24; ++i) a.in[i] = (const float*)d_in[i];
    a.out = (float*)d_out; a.ws = (unsigned char*)d_ws;
#if MK_ONE_LAUNCH
    a.ph_lo = 0; a.ph_hi = N_PHASES;
    void* kargs[] = {&a};
    hipError_t e = hipLaunchCooperativeKernel((const void*)mk_fwd, dim3(grid), dim3(NTHREADS), kargs, LDS_BYTES, stream);
    if (e != hipSuccess) fprintf(stderr, "kernel_launch: cooperative launch failed: %s\n", hipGetErrorString(e));
    if (PROBE_PHASE >= 0) { a.ph_lo = PROBE_PHASE; a.ph_hi = PROBE_PHASE + 1; hipLaunchKernelGGL(mk_fwd, dim3(grid), dim3(NTHREADS), LDS_BYTES, stream, a); }
#else
    for (int p = 0; p < N_PHASES; ++p) { a.ph_lo = p; a.ph_hi = p + 1; hipLaunchKernelGGL(mk_fwd, dim3(grid), dim3(NTHREADS), LDS_BYTES, stream, a); }
#endif
}
```
